# Optimizing an MI355X kernel written in HIP

```python
import math
import jax, jax.numpy as jnp
from jax import lax
import numpy as np

D_MODEL = 1024
BATCH = 8
SEQ = 8192
DEPTH = 2

N_A_LAYERS = DEPTH // 2
N_B_LAYERS = DEPTH - N_A_LAYERS
CHUNK = 128
A_WIDTH = D_MODEL
A_GROUPS = 8
A_GROUP_DIM = A_WIDTH // A_GROUPS
HEAD_DIM = 64
N_Q_HEADS = D_MODEL // HEAD_DIM
N_KV_HEADS = 4
GQA_GROUP = N_Q_HEADS // N_KV_HEADS
WINDOW = 128
BLOCK = 128
D_FF = 2816
CONV_WIDTH = 3
PLE_DIM = 256
EPS = 1e-6

kernel_name = "yoco_gmlp_swa_sink_hybrid"


def _alibi_slopes(n):
    return np.array([2.0 ** (-8.0 * (h + 1) / n) for h in range(n)], dtype=np.float32)


def rmsnorm(x, g):
    xf = x.astype(jnp.float32)
    y = xf * lax.rsqrt(jnp.mean(xf * xf, axis=-1, keepdims=True) + EPS)
    return (y * g.astype(jnp.float32)).astype(x.dtype)


def mixer_a(xn, w_in, g_v, w_s, b_s, w_out):
    B, S, _ = xn.shape
    z = jax.nn.gelu(xn @ w_in)
    u, v = jnp.split(z, 2, axis=-1)
    v = rmsnorm(v, g_v)
    nc = S // CHUNK
    v = v.reshape(B, nc, CHUNK, A_GROUPS, A_GROUP_DIM)
    causal = jnp.tril(jnp.ones((CHUNK, CHUNK), dtype=bool))
    w = jnp.where(causal[None], w_s, jnp.zeros((), w_s.dtype)).astype(v.dtype)
    s = jnp.einsum('hts,bcshd->bcthd', w, v) + b_s.T.astype(v.dtype)[None, None, :, :, None]
    s = s.reshape(B, S, A_WIDTH)
    return (u * s) @ w_out


def shared_kv(h, g, w_kv):
    B, S, _ = h.shape
    nb = S // BLOCK
    kv = rmsnorm(h, g) @ w_kv
    k, v = jnp.split(kv, 2, axis=-1)

    def band(t):
        tb = t.reshape(B, nb, BLOCK, N_KV_HEADS, HEAD_DIM)
        prev = jnp.pad(tb[:, :-1], ((0, 0), (1, 0), (0, 0), (0, 0), (0, 0)))
        return jnp.concatenate([prev, tb], axis=2)

    return band(k), band(v)


def mixer_b(xn, w_q, sinks, w_o, kblk, vblk):
    B, S, _ = xn.shape
    nb = S // BLOCK
    q = (xn @ w_q).reshape(B, nb, BLOCK, N_KV_HEADS, GQA_GROUP, HEAD_DIM)
    scores = jnp.einsum('bnikgd,bnjkd->bnkgij', q.astype(jnp.float32),
                        kblk.astype(jnp.float32)) * (HEAD_DIM ** -0.5)
    i = jnp.arange(BLOCK)[:, None]
    j = jnp.arange(2 * BLOCK)[None, :]
    dist = i + BLOCK - j
    in_band = (dist >= 0) & (dist < WINDOW)
    blk = jnp.arange(nb)[:, None, None]
    valid = in_band[None] & ((blk > 0) | (j[None] >= BLOCK))
    slopes = jnp.asarray(_alibi_slopes(N_Q_HEADS)).reshape(N_KV_HEADS, GQA_GROUP)
    scores = scores - slopes[:, :, None, None] * dist.astype(jnp.float32)
    scores = jnp.where(valid[None, :, None, None], scores, -jnp.inf)
    sink = sinks.astype(jnp.float32).reshape(N_KV_HEADS, GQA_GROUP)[:, :, None, None]
    m = jnp.maximum(jnp.max(scores, axis=-1, keepdims=True), sink)
    e = jnp.exp(scores - m)
    probs = e / (jnp.sum(e, axis=-1, keepdims=True) + jnp.exp(sink - m))
    out = jnp.einsum('bnkgij,bnjkd->bnikgd', probs.astype(vblk.dtype), vblk)
    return out.reshape(B, S, N_Q_HEADS * HEAD_DIM) @ w_o


def conv_ffn(xn, w_up, conv_w, conv_b, w_down):
    S = xn.shape[1]
    h = xn @ w_up
    hp = jnp.pad(h, ((0, 0), (CONV_WIDTH - 1, 0), (0, 0)))
    c = conv_b + sum(hp[:, t:t + S] * conv_w[t] for t in range(CONV_WIDTH))
    g, u = jnp.split(c, 2, axis=-1)
    return (jax.nn.silu(g) * u) @ w_down


def per_layer_embed(h, p_i, g_norm, w_in, w_gate, b_gate):
    gate = jax.nn.sigmoid(rmsnorm(h, g_norm) @ w_gate + b_gate)
    return (p_i @ w_in) * gate


def setup_inputs(seed: int = 0) -> dict:
    key = jax.random.key(seed)
    ks = jax.random.split(key, 26)
    f32 = jnp.float32

    def nrm(k, shape, scale):
        return jax.random.normal(k, shape, f32) * scale

    def gain(k, shape):
        return 1.0 + 0.02 * jax.random.normal(k, shape, f32)

    d = D_MODEL
    return {
        "x": nrm(ks[0], (BATCH, SEQ, d), 1.0),
        "p": nrm(ks[1], (DEPTH, BATCH, SEQ, PLE_DIM), 1.0),
        "norm_mix": gain(ks[2], (DEPTH, d)),
        "norm_ffn": gain(ks[3], (DEPTH, d)),
        "norm_ple": gain(ks[4], (DEPTH, d)),
        "norm_kv": gain(ks[5], (d,)),
        "norm_final": gain(ks[6], (d,)),
        "a_w_in": nrm(ks[7], (N_A_LAYERS, d, 2 * A_WIDTH), d ** -0.5),
        "a_norm_v": gain(ks[8], (N_A_LAYERS, A_WIDTH)),
        "a_w_s": nrm(ks[9], (N_A_LAYERS, A_GROUPS, CHUNK, CHUNK), CHUNK ** -0.5),
        "a_b_s": 1.0 + nrm(ks[10], (N_A_LAYERS, A_GROUPS, CHUNK), 0.02),
        "a_w_out": nrm(ks[11], (N_A_LAYERS, A_WIDTH, d), A_WIDTH ** -0.5),
        "w_kv": nrm(ks[12], (d, 2 * N_KV_HEADS * HEAD_DIM), d ** -0.5),
        "b_w_q": nrm(ks[13], (N_B_LAYERS, d, N_Q_HEADS * HEAD_DIM), d ** -0.5),
        "b_sinks": nrm(ks[14], (N_B_LAYERS, N_Q_HEADS), 0.5),
        "b_w_o": nrm(ks[15], (N_B_LAYERS, N_Q_HEADS * HEAD_DIM, d), (N_Q_HEADS * HEAD_DIM) ** -0.5),
        "f_w_up": nrm(ks[16], (DEPTH, d, 2 * D_FF), d ** -0.5),
        "f_conv_w": nrm(ks[17], (DEPTH, CONV_WIDTH, 2 * D_FF), CONV_WIDTH ** -0.5),
        "f_conv_b": nrm(ks[18], (DEPTH, 2 * D_FF), 0.01),
        "f_w_down": nrm(ks[19], (DEPTH, D_FF, d), D_FF ** -0.5),
        "ple_w_in": nrm(ks[20], (DEPTH, PLE_DIM, d), PLE_DIM ** -0.5),
        "ple_w_gate": nrm(ks[21], (DEPTH, d, d), d ** -0.5),
        "ple_b_gate": nrm(ks[22], (DEPTH, d), 0.01),
    }


def reference(x, p, norm_mix, norm_ffn, norm_ple, norm_kv, norm_final,
              a_w_in, a_norm_v, a_w_s, a_b_s, a_w_out,
              w_kv, b_w_q, b_sinks, b_w_o,
              f_w_up, f_conv_w, f_conv_b, f_w_down,
              ple_w_in, ple_w_gate, ple_b_gate):
    h = x
    kblk = None
    vblk = None
    for i in range(DEPTH):
        xn = rmsnorm(h, norm_mix[i])
        if i < N_A_LAYERS:
            a = i
            h = h + mixer_a(xn, a_w_in[a], a_norm_v[a], a_w_s[a], a_b_s[a], a_w_out[a])
        else:
            b = i - N_A_LAYERS
            h = h + mixer_b(xn, b_w_q[b], b_sinks[b], b_w_o[b], kblk, vblk)
        h = h + conv_ffn(rmsnorm(h, norm_ffn[i]), f_w_up[i], f_conv_w[i], f_conv_b[i], f_w_down[i])
        h = h + per_layer_embed(h, p[i], norm_ple[i], ple_w_in[i], ple_w_gate[i], ple_b_gate[i])
        if i == N_A_LAYERS - 1:
            kblk, vblk = shared_kv(h, norm_kv, w_kv)
    return rmsnorm(h, norm_final)
```

```cpp
#include <hip/hip_runtime.h>
#include <hip/hip_cooperative_groups.h>
#include <cstdio>
namespace cg = cooperative_groups;
namespace pg8 {
#define PG8_LAS __attribute__((address_space(3)))
typedef unsigned short bf16_t;
typedef short bf16x8 __attribute__((ext_vector_type(8)));
typedef float f32x4 __attribute__((ext_vector_type(4)));
typedef unsigned u32x4 __attribute__((ext_vector_type(4)));
constexpr int BM = 256, BK = 64, HALF = 128, HTB = HALF * BK * 2  , STAGE_BYTES = 8 * HTB, NXCD = 8, WGM = 8;

__host__ __device__ __forceinline__ int lds_byte(int r, int c) { const int st = (r >> 4) * 2 + (c >> 5), rr = r & 15, cc = c & 31, ob = rr * 64 + cc * 2; return st * 1024 + (ob ^ (((ob >> 9) & 1) << 5)); }
__host__ __device__ __forceinline__ void stage_rc(int b, int& R, int& C) { const int st = b / 1024, sb = b % 1024, swz = sb ^ (((sb >> 9) & 1) << 5); R = (st >> 1) * 16 + swz / 64; C = (st & 1) * 32 + (swz % 64) / 2; }
__host__ __device__ __forceinline__ int perm32(int rho) { const int n = rho >> 4, i = rho & 15; return 8 * (i >> 2) + 4 * n + (i & 3); }

struct Unit { int pm, pn; };
struct Gemm { const bf16_t* A; const bf16_t* Bt; int M, N, K; };

struct StaticOrder {
    int nM, nN, nwg, G, c;
    __host__ __device__ void init(int M, int N, int G_, int c_) { nM = M / BM; nN = N / BM; nwg = nM * nN; G = G_; c = c_; }
    __host__ __device__ bool next(int i, Unit& u) const {
        const long L = (long)i * G + c; if (L >= nwg) return false;
        int wgid = (int)L; { const int q = nwg / NXCD, r = nwg % NXCD, xcd = wgid % NXCD, off = wgid / NXCD; wgid = (xcd < r ? xcd * (q + 1) : r * (q + 1) + (xcd - r) * q) + off; }
        const int nig = WGM * nN, gid = wgid / nig, fm = gid * WGM, gsz = (nM - fm) < WGM ? (nM - fm) : WGM;
        u.pm = fm + ((wgid % nig) % gsz); u.pn = (wgid % nig) / gsz; return true;
    }
    __device__ __forceinline__ void a_ready(const Unit&) const {}
    __device__ __forceinline__ void done(const Unit&) const {}
};
__device__ __forceinline__ unsigned cvt_pk_bf16(float lo, float hi) { unsigned r; asm volatile("v_cvt_pk_bf16_f32 %0, %1, %2" : "=v"(r) : "v"(lo), "v"(hi)); return r; }
typedef float f32x2 __attribute__((ext_vector_type(2)));
template <class Epi, class Sched, bool STAMP = false>
__device__ __forceinline__ void gemm_phase(PG8_LAS unsigned char* lds, const Gemm g, const Sched& S, const Epi& E, unsigned long long* stamps) {
    int tid_ = threadIdx.x; asm volatile("" : "+v"(tid_));
    const int tid = tid_, wid = __builtin_amdgcn_readfirstlane(tid >> 6), lane = tid & 63, wr = wid >> 2, wc = wid & 3, fr = lane & 15, fq = lane >> 4;
    const int K = g.K, nt = K / BK;
    int ts_lo = 0, ts_hi = 0, nts = 0; const unsigned long long rt_entry = STAMP ? (unsigned long long)wall_clock64() : 0ull;
#define PG8_STAMP() do { if (STAMP && wid == 0 && nts < 64) { const unsigned long long _c = (unsigned long long)clock64(); \
        ts_lo = (lane == nts) ? (int)(unsigned)_c : ts_lo; ts_hi = (lane == nts) ? (int)(unsigned)(_c >> 32) : ts_hi; ++nts; } } while (0)
    PG8_STAMP();
    unsigned voffA[2], voffB[2];
#pragma unroll
    for (int i = 0; i < 2; ++i) { int R, C; stage_rc(tid * 16 + i * 8192, R, C); const int Rb = Epi::PERM ? ((R & ~31) + perm32(R & 31)) : R;
        voffA[i] = (unsigned)(R * K + C) * 2u; voffB[i] = (unsigned)(Rb * K + C) * 2u; }
    const size_t kstep = (size_t)(BK * 2);
    const size_t hstep = (size_t)HALF * K * 2;
    const size_t tstep = 2 * hstep;
    const unsigned ldsw = (unsigned)wid * 1024u;
    const int aoff = lds_byte(wr * 64 + fr, fq * 8), boff = lds_byte(wc * 32 + fr, fq * 8);
#define PG8_SA(b, h) (((b) * 2 + (h)) * HTB)
#define PG8_SB(b, h) ((4 + (b) * 2 + (h)) * HTB)
#define PG8_STAGE(bufoff, gbase, voff) do { _Pragma("unroll") for (int _i = 0; _i < 2; ++_i) \
        __builtin_amdgcn_global_load_lds((const unsigned*)((const char*)(gbase) + (voff)[_i]), (PG8_LAS unsigned*)(lds + (bufoff) + ldsw + _i * 8192), 16, 0, 0); } while (0)
#define PG8_LDA(dst, b, h) do { _Pragma("unroll") for (int m = 0; m < 4; ++m) _Pragma("unroll") for (int k = 0; k < 2; ++k) dst[m][k] = *(const PG8_LAS bf16x8*)(lds + PG8_SA(b, h) + aoff + m * 2048 + k * 1024); } while (0)
#define PG8_LDB(dst, b, h) do { _Pragma("unroll") for (int n = 0; n < 2; ++n) _Pragma("unroll") for (int k = 0; k < 2; ++k) dst[n][k] = *(const PG8_LAS bf16x8*)(lds + PG8_SB(b, h) + boff + n * 2048 + k * 1024); } while (0)
#define PG8_MMA(ai, bj, At, Bt) do { __builtin_amdgcn_s_setprio(1); _Pragma("unroll") for (int m = 0; m < 4; ++m) _Pragma("unroll") for (int n = 0; n < 2; ++n) _Pragma("unroll") for (int k = 0; k < 2; ++k) \
        acc[ai][bj][m][n] = __builtin_amdgcn_mfma_f32_16x16x32_bf16(Bt[n][k], At[m][k], acc[ai][bj][m][n], 0, 0, 0); __builtin_amdgcn_s_setprio(0); } while (0)
#define PG8_WAIT_V(n) asm volatile("s_waitcnt vmcnt(" #n ")" ::: "memory")
#define PG8_WAIT_L(n) asm volatile("s_waitcnt lgkmcnt(" #n ")" ::: "memory")
#define PG8_BAR __builtin_amdgcn_s_barrier()
#define PG8_SCHED __builtin_amdgcn_sched_barrier(0)
    Unit cur, nxt; int ui = 0;
    if (!S.next(0, cur)) return;
    f32x4 acc[2][2][4][2];
#pragma unroll
    for (int a = 0; a < 2; ++a)
#pragma unroll
        for (int b = 0; b < 2; ++b)
#pragma unroll
            for (int m = 0; m < 4; ++m)
#pragma unroll
                for (int n = 0; n < 2; ++n) acc[a][b][m][n] = (f32x4){0.f, 0.f, 0.f, 0.f};
    bf16x8 At[4][2], B0[2][2], B1[2][2];
    const char* cA = (const char*)g.A + (size_t)cur.pm * tstep; const char* cB = (const char*)g.Bt + (size_t)cur.pn * tstep;
    S.a_ready(cur);
    PG8_STAGE(PG8_SB(0, 0), cB, voffB); PG8_STAGE(PG8_SA(0, 0), cA, voffA); PG8_STAGE(PG8_SB(0, 1), cB + hstep, voffB); PG8_STAGE(PG8_SA(0, 1), cA + hstep, voffA);
    if (wr == 1) PG8_BAR;
    PG8_WAIT_V(4); PG8_BAR;
    PG8_STAGE(PG8_SB(1, 0), cB + kstep, voffB); PG8_STAGE(PG8_SA(1, 0), cA + kstep, voffA); PG8_STAGE(PG8_SB(1, 1), cB + hstep + kstep, voffB);
    PG8_WAIT_V(6); PG8_BAR;
    PG8_STAMP();
    for (;;) {
        const bool has_next = S.next(ui + 1, nxt);
        const char* nA = has_next ? (const char*)g.A + (size_t)nxt.pm * tstep : cA; const char* nB = has_next ? (const char*)g.Bt + (size_t)nxt.pn * tstep : cB;
        for (int t = 0; t < nt; t += 2) {
            const bool last = (t == nt - 2);
            const char* a1 = cA + (size_t)(t + 1) * kstep;
            const char* a2 = last ? nA : cA + (size_t)(t + 2) * kstep; const char* b2 = last ? nB : cB + (size_t)(t + 2) * kstep;
            const char* a3 = a2 + kstep; const char* b3 = b2 + kstep;
            if (last && has_next) S.a_ready(nxt);
            PG8_LDB(B0, 0, 0); PG8_SCHED; PG8_LDA(At, 0, 0); PG8_STAGE(PG8_SA(1, 1), a1 + hstep, voffA);
            PG8_WAIT_L(8); PG8_BAR; PG8_WAIT_L(0); PG8_MMA(0, 0, At, B0); PG8_BAR; PG8_SCHED;
            PG8_LDB(B1, 0, 1); PG8_STAGE(PG8_SB(0, 0), b2, voffB);
            PG8_BAR; PG8_WAIT_L(0); PG8_MMA(0, 1, At, B1); PG8_BAR;
            PG8_LDA(At, 0, 1); PG8_STAGE(PG8_SA(0, 0), a2, voffA);
            PG8_BAR; PG8_WAIT_L(0); PG8_MMA(1, 0, At, B0); PG8_BAR; PG8_SCHED;
            PG8_STAGE(PG8_SB(0, 1), b2 + hstep, voffB);
            PG8_WAIT_V(6); PG8_BAR; PG8_MMA(1, 1, At, B1); PG8_BAR;
            PG8_LDB(B0, 1, 0); PG8_SCHED; PG8_LDA(At, 1, 0); PG8_STAGE(PG8_SA(0, 1), a2 + hstep, voffA);
            PG8_WAIT_L(8); PG8_BAR; PG8_WAIT_L(0); PG8_MMA(0, 0, At, B0); PG8_BAR; PG8_SCHED;
            PG8_LDB(B1, 1, 1); PG8_STAGE(PG8_SB(1, 0), b3, voffB);
            PG8_BAR; PG8_WAIT_L(0); PG8_MMA(0, 1, At, B1); PG8_BAR;
            PG8_LDA(At, 1, 1); PG8_STAGE(PG8_SA(1, 0), a3, voffA);
            PG8_BAR; PG8_WAIT_L(0); PG8_MMA(1, 0, At, B0); PG8_BAR; PG8_SCHED;
            PG8_STAGE(PG8_SB(1, 1), b3 + hstep, voffB);
            PG8_WAIT_V(6); PG8_BAR; PG8_MMA(1, 1, At, B1); PG8_BAR;
        }
        PG8_STAMP();
        if constexpr (!Epi::AFTER_DRAIN) { E(acc, cur, wr, wc, fr, fq); S.done(cur); }
        PG8_STAMP();
        if (!has_next) break;
#pragma unroll
        for (int a = 0; a < 2; ++a)
#pragma unroll
            for (int b = 0; b < 2; ++b)
#pragma unroll
                for (int m = 0; m < 4; ++m)
#pragma unroll
                    for (int n = 0; n < 2; ++n) acc[a][b][m][n] = (f32x4){0.f, 0.f, 0.f, 0.f};
        cur = nxt; cA = nA; cB = nB; ++ui;
    }
    PG8_WAIT_V(0);
    if (wr == 0) PG8_BAR;
    PG8_BAR;
    if constexpr (Epi::AFTER_DRAIN) { E.fused(acc, cur, wr, wc, fr, fq, lds, wid, lane); S.done(cur); }
    PG8_STAMP();
    if (STAMP && wid == 0) { stamps[lane] = lane < nts ? (((unsigned long long)(unsigned)ts_hi << 32) | (unsigned)ts_lo) : 0ull;
        if (lane == 62) stamps[62] = rt_entry; if (lane == 63) stamps[63] = (unsigned long long)wall_clock64(); }
#undef PG8_STAMP
#undef PG8_SA
#undef PG8_SB
#undef PG8_STAGE
#undef PG8_LDA
#undef PG8_LDB
#undef PG8_MMA
#undef PG8_WAIT_V
#undef PG8_WAIT_L
#undef PG8_BAR
#undef PG8_SCHED
}
}

namespace mk {
using pg8::bf16x8; using pg8::f32x4; using pg8::Unit;
#define LAS __attribute__((address_space(3)))
typedef unsigned short bf16;
typedef unsigned v4u __attribute__((ext_vector_type(4)));
typedef unsigned v2u __attribute__((ext_vector_type(2)));
typedef float f32x16 __attribute__((ext_vector_type(16)));
typedef float f32x2_t __attribute__((ext_vector_type(2)));
typedef __bf16 bf16x2_t __attribute__((ext_vector_type(2)));

constexpr int T = 65536, D = 1024, SEQ = 8192, DFF = 2816, NUP = 5632, TH = 32768  ;
constexpr float EPS = 1e-6f;
constexpr size_t MiB = (size_t)1 << 20;
constexpr size_t WS_WIN = 1 * MiB, WS_WOUT = 5 * MiB, WS_WQKV = 7 * MiB, WS_WO = 10 * MiB, WS_WUP = 12 * MiB, WS_WDN = 34 * MiB, WS_WPE = 45 * MiB, WS_WG = 46 * MiB, WS_WS = 50 * MiB;
constexpr size_t WS_SSQ = 56 * MiB;
constexpr size_t WS_PB = 88 * MiB;
constexpr size_t WS_HA = 152 * MiB, WS_HB = 280 * MiB;
constexpr size_t WS_PE = 408 * MiB;
constexpr size_t WS_BIG = 536 * MiB;
constexpr size_t WS_HUP = 408 * MiB, WS_ACT = 760 * MiB;
constexpr size_t WS_END = 1024 * MiB;
constexpr int LDS_BYTES = 147456;

struct Args {
    const float* in[23]; float* out; unsigned char* ws; int op_lo, op_hi;
};
typedef LAS const unsigned long long* PTT;
__device__ __forceinline__ unsigned long long ldp(PTT PT, int i) {
    asm volatile("" ::: "memory");
    const unsigned long long v = PT[i];
    const unsigned lo = __builtin_amdgcn_readfirstlane((unsigned)v), hi = __builtin_amdgcn_readfirstlane((unsigned)(v >> 32));
    return ((unsigned long long)hi << 32) | lo;
}
#define INP(i) ((const float*)ldp(PT, (i)))
#define OUTP ((float*)ldp(PT, 23))
#define WSP ((unsigned char*)ldp(PT, 24))

__device__ __forceinline__ int opaque_tid() { int t = threadIdx.x; asm volatile("" : "+v"(t)); return t; }
__device__ __forceinline__ int opaque_bid() { int b = blockIdx.x; asm volatile("" : "+s"(b)); return b; }
__device__ __forceinline__ unsigned f2bf(float f) { unsigned u = __builtin_bit_cast(unsigned, f); return (u + 0x7fffu + ((u >> 16) & 1u)) >> 16; }
__device__ __forceinline__ unsigned pk2(float lo, float hi) { f32x2_t v = {lo, hi}; bf16x2_t b = __builtin_convertvector(v, bf16x2_t); return __builtin_bit_cast(unsigned, b); }
__device__ __forceinline__ float bflo(unsigned w) { return __builtin_bit_cast(float, w << 16); }
__device__ __forceinline__ float bfhi(unsigned w) { return __builtin_bit_cast(float, w & 0xffff0000u); }
__device__ __forceinline__ float bf2f(bf16 b) { return __builtin_bit_cast(float, ((unsigned)b) << 16); }
__device__ __forceinline__ float fast_sigmoid(float x) { return __builtin_amdgcn_rcpf(1.0f + __expf(-x)); }
__device__ __forceinline__ float gelu_tanh(float x) { const float y = x * (1.5957691216f + 0.0713548163f * x * x); return x * __builtin_amdgcn_rcpf(1.0f + __expf(-y)); }
__device__ __forceinline__ float row_rstd(const float* ssq, size_t row) {
    const f32x4* p = (const f32x4*)(ssq + row * 16);
    const f32x4 a = p[0], b = p[1], c = p[2], d = p[3];
    const float s = ((a[0] + a[1]) + (a[2] + a[3])) + ((b[0] + b[1]) + (b[2] + b[3])) + ((c[0] + c[1]) + (c[2] + c[3])) + ((d[0] + d[1]) + (d[2] + d[3]));
    return rsqrtf(s * (1.0f / 1024.0f) + EPS);
}
__device__ __forceinline__ float wave_sum(float v) {
#pragma unroll
    for (int o = 1; o < 64; o <<= 1) v += __shfl_xor(v, o);
    return v;
}

enum { EM_PLAIN = 0, EM_GELU = 1, EM_RES = 2, EM_SCALE = 3, EM_GATE = 4, EM_QKV = 5 };
struct Epi {
    static constexpr bool PERM = true, AFTER_DRAIN = false;
    int mode; bf16* out; int ldo; const bf16* res; const bf16* pe; const float* ssq_in; float* ssq_out; const float* bias; bf16* out_k; bf16* out_v;
    __device__ __forceinline__ void operator()(const f32x4 (&acc)[2][2][4][2], const Unit& u, int wr, int wc, int fr, int fq) const {
        const int row0 = u.pm * 256 + wr * 64 + fr;
        const int colt = u.pn * 256, cw = wc * 32 + 8 * fq;
        bf16* obase = out; int old = ldo, ocol = colt;
        if (mode == EM_QKV) { if (u.pn == 4) { obase = out_k; old = 256; ocol = 0; } else if (u.pn == 5) { obase = out_v; old = 256; ocol = 0; } }
        const bool use_rs = (mode == EM_GELU) | (mode == EM_SCALE) | (mode == EM_GATE) | (mode == EM_QKV);
        const bool do_ssq = (mode == EM_RES) | (mode == EM_GATE) | ((mode == EM_GELU) & (u.pn >= 4));
        const int slot = ((mode == EM_GELU) ? (u.pn - 4) : u.pn) * 4 + wc;
#pragma unroll
        for (int ai = 0; ai < 2; ++ai)
#pragma unroll
            for (int m = 0; m < 4; ++m) {
                const size_t row = (size_t)(row0 + ai * 128 + m * 16);
                float rs = 1.0f;
                if (use_rs) rs = row_rstd(ssq_in, row);
                float sq = 0.f;
#pragma unroll
                for (int bj = 0; bj < 2; ++bj) {
                    const int col = colt + bj * 128 + cw;
                    f32x4 v0 = acc[ai][bj][m][0] * rs, v1 = acc[ai][bj][m][1] * rs;
                    if (mode == EM_GELU) {
#pragma unroll
                        for (int j = 0; j < 4; ++j) { v0[j] = gelu_tanh(v0[j]); v1[j] = gelu_tanh(v1[j]); }
                    } else if (mode == EM_RES) {
                        const v4u r = *(const v4u*)(res + row * 1024 + col);
                        v0[0] += bflo(r.x); v0[1] += bfhi(r.x); v0[2] += bflo(r.y); v0[3] += bfhi(r.y);
                        v1[0] += bflo(r.z); v1[1] += bfhi(r.z); v1[2] += bflo(r.w); v1[3] += bfhi(r.w);
                    } else if (mode == EM_GATE) {
                        const v4u r = *(const v4u*)(res + row * 1024 + col);
                        const v4u e = *(const v4u*)(pe + row * 1024 + col);
                        const f32x4 b0 = *(const f32x4*)(bias + col), b1 = *(const f32x4*)(bias + col + 4);
                        v0[0] = bflo(r.x) + bflo(e.x) * fast_sigmoid(v0[0] + b0[0]); v0[1] = bfhi(r.x) + bfhi(e.x) * fast_sigmoid(v0[1] + b0[1]);
                        v0[2] = bflo(r.y) + bflo(e.y) * fast_sigmoid(v0[2] + b0[2]); v0[3] = bfhi(r.y) + bfhi(e.y) * fast_sigmoid(v0[3] + b0[3]);
                        v1[0] = bflo(r.z) + bflo(e.z) * fast_sigmoid(v1[0] + b1[0]); v1[1] = bfhi(r.z) + bfhi(e.z) * fast_sigmoid(v1[1] + b1[1]);
                        v1[2] = bflo(r.w) + bflo(e.w) * fast_sigmoid(v1[2] + b1[2]); v1[3] = bfhi(r.w) + bfhi(e.w) * fast_sigmoid(v1[3] + b1[3]);
                    }
                    sq += (v0[0] * v0[0] + v0[1] * v0[1]) + (v0[2] * v0[2] + v0[3] * v0[3]) + (v1[0] * v1[0] + v1[1] * v1[1]) + (v1[2] * v1[2] + v1[3] * v1[3]);
                    v4u w; w.x = pk2(v0[0], v0[1]); w.y = pk2(v0[2], v0[3]); w.z = pk2(v1[0], v1[1]); w.w = pk2(v1[2], v1[3]);
                    *(v4u*)(obase + row * (size_t)old + (ocol + bj * 128 + cw)) = w;
                }
                if (do_ssq) {
                    sq += __shfl_xor(sq, 16); sq += __shfl_xor(sq, 32);
                    if (fq == 0) ssq_out[row * 16 + slot] = sq;
                }
            }
    }
};

__device__ __forceinline__ void transpose_item(const float* W, int K, int N, bf16* WT, int row_off, const float* gain, LAS float* scr, int item, int lane) {
    const int nblk = N / 32, kb = item / nblk, nb = item % nblk, k0 = 64 * kb, n0 = 32 * nb;
#pragma unroll 8
    for (int i = 0; i < 32; ++i) { const int kk = 2 * i + (lane >> 5); const float gsc = gain ? gain[k0 + kk] : 1.0f; scr[kk * 33 + (lane & 31)] = W[(size_t)(k0 + kk) * N + n0 + (lane & 31)] * gsc; }
    asm volatile("s_waitcnt lgkmcnt(0)" ::: "memory");
    const int c = lane & 7;
#pragma unroll
    for (int j = 0; j < 4; ++j) { const int n = (lane >> 3) + 8 * j; const LAS float* s = scr + (8 * c) * 33 + n;
        v4u o; o.x = pk2(s[0 * 33], s[1 * 33]); o.y = pk2(s[2 * 33], s[3 * 33]); o.z = pk2(s[4 * 33], s[5 * 33]); o.w = pk2(s[6 * 33], s[7 * 33]);
        *(v4u*)(WT + (size_t)(row_off + n0 + n) * K + k0 + 8 * c) = o; }
    asm volatile("s_waitcnt lgkmcnt(0)" ::: "memory");
}

__device__ __forceinline__ void prologue(PTT PT, LAS unsigned char* lds) {
    const int tid = opaque_tid(), bid = opaque_bid(), lane = tid & 63, wave = tid >> 6;
    const int gw = bid * 8 + wave, NGW = gridDim.x * 8;
    LAS float* scr = (LAS float*)(lds + wave * 16384);
    unsigned char* ws = WSP;
    for (int mi = 0; mi < 13; ++mi) {
        const float* W; int K, N, ro = 0; bf16* WT; const float* gain = nullptr;
        switch (mi) {
            case 0: W = INP(7); K = 1024; N = 2048; WT = (bf16*)(ws + WS_WIN); gain = INP(2); break;
            case 1: W = INP(11); K = 1024; N = 1024; WT = (bf16*)(ws + WS_WOUT); break;
            case 2: W = INP(13); K = 1024; N = 1024; WT = (bf16*)(ws + WS_WQKV); gain = INP(2) + 1024; break;
            case 3: W = INP(12); K = 1024; N = 512; WT = (bf16*)(ws + WS_WQKV); ro = 1024; gain = INP(5); break;
            case 4: W = INP(15); K = 1024; N = 1024; WT = (bf16*)(ws + WS_WO); break;
            case 5: W = INP(16); K = 1024; N = NUP; WT = (bf16*)(ws + WS_WUP); gain = INP(3); break;
            case 6: W = INP(16) + (size_t)1024 * NUP; K = 1024; N = NUP; WT = (bf16*)(ws + WS_WUP) + (size_t)NUP * 1024; gain = INP(3) + 1024; break;
            case 7: W = INP(19); K = DFF; N = 1024; WT = (bf16*)(ws + WS_WDN); break;
            case 8: W = INP(19) + (size_t)DFF * 1024; K = DFF; N = 1024; WT = (bf16*)(ws + WS_WDN) + (size_t)1024 * DFF; break;
            case 9: W = INP(20); K = 256; N = 1024; WT = (bf16*)(ws + WS_WPE); break;
            case 10: W = INP(20) + (size_t)256 * 1024; K = 256; N = 1024; WT = (bf16*)(ws + WS_WPE) + (size_t)1024 * 256; break;
            case 11: W = INP(21); K = 1024; N = 1024; WT = (bf16*)(ws + WS_WG); gain = INP(4); break;
            default: W = INP(21) + (size_t)1024 * 1024; K = 1024; N = 1024; WT = (bf16*)(ws + WS_WG) + (size_t)1024 * 1024; gain = INP(4) + 1024; break;
        }
        const int nitems = (K / 64) * (N / 32);
        for (int it = gw; it < nitems; it += NGW) transpose_item(W, K, N, WT, ro, gain, scr, it, lane);
    }
    {
        const float* w = INP(9); bf16* o = (bf16*)(ws + WS_WS);
        for (int i = bid * 512 + tid; i < 8 * 128 * 128; i += gridDim.x * 512) { const int s = i & 127, t = (i >> 7) & 127; o[i] = (bf16)f2bf(s <= t ? w[i] : 0.0f); }
    }
    {
        const float* x = INP(0); bf16* xb = (bf16*)(ws + WS_HA); float* ssq0 = (float*)(ws + WS_SSQ);
        for (int r = gw; r < T; r += NGW) {
            const f32x4* xr = (const f32x4*)(x + (size_t)r * D) + lane; float s = 0.f;
            unsigned long long* o8 = (unsigned long long*)(xb + (size_t)r * D) + lane;
#pragma unroll
            for (int j = 0; j < 4; ++j) { const f32x4 v = xr[64 * j]; s += (v[0] * v[0] + v[1] * v[1]) + (v[2] * v[2] + v[3] * v[3]);
                o8[64 * j] = (unsigned long long)pk2(v[0], v[1]) | ((unsigned long long)pk2(v[2], v[3]) << 32); }
            s = wave_sum(s);
            if (lane < 16) ssq0[(size_t)r * 16 + lane] = (lane == 0) ? s : 0.f;
        }
    }
    {
        const f32x4* p4 = (const f32x4*)INP(1); unsigned long long* o8 = (unsigned long long*)(ws + WS_PB);
        const size_t n4 = (size_t)2 * T * 256 / 4;
        for (size_t i = (size_t)bid * 512 + tid; i < n4; i += (size_t)gridDim.x * 512) { const f32x4 v = p4[i]; o8[i] = (unsigned long long)pk2(v[0], v[1]) | ((unsigned long long)pk2(v[2], v[3]) << 32); }
    }
}

__device__ __forceinline__ void spatial_phase(PTT PT, LAS unsigned char* lds) {
    const int tid = opaque_tid(), bid = opaque_bid(), lane = tid & 63, wave = __builtin_amdgcn_readfirstlane(tid >> 6), r = lane & 31, hh = lane >> 5;
    unsigned char* ws = WSP;
    const bf16* z = (const bf16*)(ws + WS_BIG); bf16* us = (bf16*)(ws + WS_BIG + 256 * MiB);
    const float* ssq1 = (const float*)(ws + WS_SSQ + 1 * 4 * MiB);
    const bf16* Wsb = (const bf16*)(ws + WS_WS);
    const float* gv = INP(8); const float* bs = INP(10);
    LAS unsigned* vT32 = (LAS unsigned*)lds;
    LAS unsigned char* vTb = lds;
    for (int u = bid; u < 4096; u += gridDim.x) {
        const int h = u & 7, c = u >> 3; const size_t tok0 = (size_t)c * 128;
        __syncthreads();
        {
            const int p = tid & 63; const size_t ra = tok0 + 2 * p, rb = ra + 1;
            const float rsa = row_rstd(ssq1, ra), rsb = row_rstd(ssq1, rb);
#pragma unroll
            for (int it = 0; it < 2; ++it) {
                const int cc = (tid >> 6) + 8 * it;
                const v4u va = *(const v4u*)(z + ra * 2048 + 1024 + h * 128 + cc * 8), vb = *(const v4u*)(z + rb * 2048 + 1024 + h * 128 + cc * 8);
                const f32x4 g0 = *(const f32x4*)(gv + h * 128 + cc * 8), g1 = *(const f32x4*)(gv + h * 128 + cc * 8 + 4);
                LAS unsigned* dst = vT32 + (cc * 8) * 68 + p;
                dst[0 * 68] = pk2(bflo(va.x) * rsa * g0[0], bflo(vb.x) * rsb * g0[0]);
                dst[1 * 68] = pk2(bfhi(va.x) * rsa * g0[1], bfhi(vb.x) * rsb * g0[1]);
                dst[2 * 68] = pk2(bflo(va.y) * rsa * g0[2], bflo(vb.y) * rsb * g0[2]);
                dst[3 * 68] = pk2(bfhi(va.y) * rsa * g0[3], bfhi(vb.y) * rsb * g0[3]);
                dst[4 * 68] = pk2(bflo(va.z) * rsa * g1[0], bflo(vb.z) * rsb * g1[0]);
                dst[5 * 68] = pk2(bfhi(va.z) * rsa * g1[1], bfhi(vb.z) * rsb * g1[1]);
                dst[6 * 68] = pk2(bflo(va.w) * rsa * g1[2], bflo(vb.w) * rsb * g1[2]);
                dst[7 * 68] = pk2(bfhi(va.w) * rsa * g1[3], bfhi(vb.w) * rsb * g1[3]);
            }
        }
        __syncthreads();
        const int tt = wave >> 1, dd0 = (wave & 1) * 2;
        f32x16 acc0, acc1;
#pragma unroll
        for (int i = 0; i < 16; ++i) { acc0[i] = 0.f; acc1[i] = 0.f; }
        const bf16* wrow = Wsb + ((size_t)(h * 128 + 32 * tt + r)) * 128 + 8 * hh;
        const LAS unsigned char* b0p = vTb + (32 * dd0 + r) * 272 + 16 * hh, * b1p = b0p + 32 * 272;
        const int nks = 2 * tt + 2;
        for (int ks = 0; ks < nks; ++ks) {
            const bf16x8 af = *(const bf16x8*)(wrow + 16 * ks);
            const bf16x8 bf0 = *(const LAS bf16x8*)(b0p + 32 * ks), bf1 = *(const LAS bf16x8*)(b1p + 32 * ks);
            acc0 = __builtin_amdgcn_mfma_f32_32x32x16_bf16(af, bf0, acc0, 0, 0, 0);
            acc1 = __builtin_amdgcn_mfma_f32_32x32x16_bf16(af, bf1, acc1, 0, 0, 0);
        }
#pragma unroll
        for (int reg = 0; reg < 16; ++reg) {
            const int t = 32 * tt + (reg & 3) + 8 * (reg >> 2) + 4 * hh;
            const float bias = bs[h * 128 + t];
            const size_t tok = tok0 + t; const int ch = h * 128 + 32 * dd0 + r;
            const float u0 = bf2f(z[tok * 2048 + ch]), u1 = bf2f(z[tok * 2048 + ch + 32]);
            us[tok * 1024 + ch] = (bf16)f2bf(u0 * (acc0[reg] + bias));
            us[tok * 1024 + ch + 32] = (bf16)f2bf(u1 * (acc1[reg] + bias));
        }
    }
}

__device__ __forceinline__ void conv_phase(const bf16* hup, bf16* act, const float* cw, const float* cb) {
    constexpr int R = 16, NCH = DFF / 8;
    const int nitems = (TH / R) * NCH;
    for (int it = opaque_bid() * 512 + opaque_tid(); it < nitems; it += gridDim.x * 512) {
        const int cc = it % NCH, run = it / NCH, t0 = run * R, col = cc * 8;
        float wg[3][8], wu[3][8], bg[8], bu[8];
#pragma unroll
        for (int tau = 0; tau < 3; ++tau)
#pragma unroll
            for (int q = 0; q < 2; ++q) { const f32x4 g4 = *(const f32x4*)(cw + tau * NUP + col + 4 * q), u4 = *(const f32x4*)(cw + tau * NUP + DFF + col + 4 * q);
#pragma unroll
                for (int j = 0; j < 4; ++j) { wg[tau][4 * q + j] = g4[j]; wu[tau][4 * q + j] = u4[j]; } }
#pragma unroll
        for (int q = 0; q < 2; ++q) { const f32x4 g4 = *(const f32x4*)(cb + col + 4 * q), u4 = *(const f32x4*)(cb + DFF + col + 4 * q);
#pragma unroll
            for (int j = 0; j < 4; ++j) { bg[4 * q + j] = g4[j]; bu[4 * q + j] = u4[j]; } }
        v4u g2 = {0u, 0u, 0u, 0u}, g1 = g2, u2 = g2, u1 = g2;
        if ((t0 & (SEQ - 1)) != 0) {
            g2 = *(const v4u*)(hup + (size_t)(t0 - 2) * NUP + col); u2 = *(const v4u*)(hup + (size_t)(t0 - 2) * NUP + DFF + col);
            g1 = *(const v4u*)(hup + (size_t)(t0 - 1) * NUP + col); u1 = *(const v4u*)(hup + (size_t)(t0 - 1) * NUP + DFF + col);
        }
#pragma unroll 4
        for (int rr = 0; rr < R; ++rr) {
            const size_t t = (size_t)(t0 + rr);
            const v4u g0 = *(const v4u*)(hup + t * NUP + col), u0 = *(const v4u*)(hup + t * NUP + DFF + col);
            unsigned ow[4];
#pragma unroll
            for (int q = 0; q < 4; ++q) {
                const float cgl = bg[2 * q] + wg[0][2 * q] * bflo(g2[q]) + wg[1][2 * q] * bflo(g1[q]) + wg[2][2 * q] * bflo(g0[q]);
                const float cgh = bg[2 * q + 1] + wg[0][2 * q + 1] * bfhi(g2[q]) + wg[1][2 * q + 1] * bfhi(g1[q]) + wg[2][2 * q + 1] * bfhi(g0[q]);
                const float cul = bu[2 * q] + wu[0][2 * q] * bflo(u2[q]) + wu[1][2 * q] * bflo(u1[q]) + wu[2][2 * q] * bflo(u0[q]);
                const float cuh = bu[2 * q + 1] + wu[0][2 * q + 1] * bfhi(u2[q]) + wu[1][2 * q + 1] * bfhi(u1[q]) + wu[2][2 * q + 1] * bfhi(u0[q]);
                ow[q] = pk2(cgl * fast_sigmoid(cgl) * cul, cgh * fast_sigmoid(cgh) * cuh);
            }
            v4u o; o.x = ow[0]; o.y = ow[1]; o.z = ow[2]; o.w = ow[3];
            *(v4u*)(act + t * DFF + col) = o;
            g2 = g1; g1 = g0; u2 = u1; u1 = u0;
        }
    }
}

__device__ __forceinline__ void attn_phase(PTT PT, LAS unsigned char* lds) {
    const int tid = opaque_tid(), bid = opaque_bid(), lane = tid & 63, wave = __builtin_amdgcn_readfirstlane(tid >> 6), r = lane & 31, hh = lane >> 5;
    unsigned char* ws = WSP;
    const bf16* qb = (const bf16*)(ws + WS_BIG); const bf16* kb = (const bf16*)(ws + WS_BIG + 128 * MiB); const bf16* vb = (const bf16*)(ws + WS_BIG + 160 * MiB);
    bf16* ao = (bf16*)(ws + WS_BIG + 192 * MiB);
    const float* sinks = INP(14);
    LAS unsigned char* Ks = lds;
    LAS unsigned* Vt32 = (LAS unsigned*)(lds + 36864);
    LAS unsigned char* Vtb = lds + 36864;
    for (int u = bid; u < 2048; u += gridDim.x) {
        const int kvh = u & 3, nb = (u >> 2) & 63, b = u >> 8;
        const long t0 = (long)b * SEQ + (long)nb * 128;
        __syncthreads();
#pragma unroll
        for (int it = 0; it < 4; ++it) {
            const int idx = tid + 512 * it, row = idx >> 3, c = idx & 7; const long tok = t0 - 128 + row;
            v4u val = {0u, 0u, 0u, 0u};
            if (nb > 0 || row >= 128) val = *(const v4u*)(kb + tok * 256 + kvh * 64 + c * 8);
            *(LAS v4u*)(Ks + row * 144 + c * 16) = val;
        }
#pragma unroll
        for (int it = 0; it < 2; ++it) {
            const int p = tid & 127, c = (tid >> 7) + 4 * it; const long tok = t0 - 128 + 2 * p;
            v4u va = {0u, 0u, 0u, 0u}, vbv = va;
            if (nb > 0 || p >= 64) { va = *(const v4u*)(vb + tok * 256 + kvh * 64 + c * 8); vbv = *(const v4u*)(vb + (tok + 1) * 256 + kvh * 64 + c * 8); }
            LAS unsigned* dst = Vt32 + (c * 8) * 130 + p;
            dst[0 * 130] = (va.x & 0xffffu) | (vbv.x << 16); dst[1 * 130] = (va.x >> 16) | (vbv.x & 0xffff0000u);
            dst[2 * 130] = (va.y & 0xffffu) | (vbv.y << 16); dst[3 * 130] = (va.y >> 16) | (vbv.y & 0xffff0000u);
            dst[4 * 130] = (va.z & 0xffffu) | (vbv.z << 16); dst[5 * 130] = (va.z >> 16) | (vbv.z & 0xffff0000u);
            dst[6 * 130] = (va.w & 0xffffu) | (vbv.w << 16); dst[7 * 130] = (va.w >> 16) | (vbv.w & 0xffff0000u);
        }
        __syncthreads();
#pragma unroll 1
        for (int i = 0; i < 2; ++i) {
            const int wu = wave + 8 * i, g = wu & 3, qt = wu >> 2, head = kvh * 4 + g, i0 = 32 * qt;
            bf16x8 qf[4];
            const bf16* qrow = qb + (size_t)(t0 + i0 + r) * 1024 + head * 64 + 8 * hh;
#pragma unroll
            for (int ks = 0; ks < 4; ++ks) qf[ks] = *(const bf16x8*)(qrow + 16 * ks);
            const float slope = exp2f(-0.5f * (float)(head + 1)), sink = sinks[head];
            float mrun = sink, lrun = 1.0f;
            f32x16 o0, o1;
#pragma unroll
            for (int e = 0; e < 16; ++e) { o0[e] = 0.f; o1[e] = 0.f; }
            const int kk_lo = (nb > 0) ? 0 : ((qt < 4) ? 4 - qt : 0);
#pragma unroll 1
            for (int kk = kk_lo; kk < 5; ++kk) {
                f32x16 sc;
#pragma unroll
                for (int e = 0; e < 16; ++e) sc[e] = 0.f;
                const LAS unsigned char* kp = Ks + (32 * (qt + kk) + r) * 144 + 16 * hh;
#pragma unroll
                for (int ks = 0; ks < 4; ++ks) { const bf16x8 kf = *(const LAS bf16x8*)(kp + 32 * ks); sc = __builtin_amdgcn_mfma_f32_32x32x16_bf16(kf, qf[ks], sc, 0, 0, 0); }
                const int rdk = r + 128 - 32 * kk - 4 * hh;
                float tmax = -INFINITY;
#pragma unroll
                for (int e = 0; e < 16; ++e) {
                    const int ce = (e & 3) + 8 * (e >> 2);
                    const int dist = rdk - ce;
                    float sv = fmaf(-slope, (float)dist, sc[e] * 0.125f);
                    sv = ((unsigned)dist < 128u) ? sv : -INFINITY;
                    sc[e] = sv; tmax = fmaxf(tmax, sv);
                }
                tmax = fmaxf(tmax, __shfl_xor(tmax, 32));
                const float mnew = fmaxf(mrun, tmax), alpha = __expf(mrun - mnew);
                float tsum = 0.f;
#pragma unroll
                for (int e = 0; e < 16; ++e) { const float ev = __expf(sc[e] - mnew); sc[e] = ev; tsum += ev; }
                tsum += __shfl_xor(tsum, 32);
                lrun = lrun * alpha + tsum; mrun = mnew;
#pragma unroll
                for (int e = 0; e < 16; ++e) { const float ae = __shfl(alpha, (e & 3) + 8 * (e >> 2) + 4 * hh); o0[e] *= ae; o1[e] *= ae; }
#pragma unroll
                for (int s2 = 0; s2 < 2; ++s2) {
                    v4u pw;
                    pw.x = pk2(sc[8 * s2 + 0], sc[8 * s2 + 1]); pw.y = pk2(sc[8 * s2 + 2], sc[8 * s2 + 3]);
                    pw.z = pk2(sc[8 * s2 + 4], sc[8 * s2 + 5]); pw.w = pk2(sc[8 * s2 + 6], sc[8 * s2 + 7]);
                    const bf16x8 pa = __builtin_bit_cast(bf16x8, pw);
                    const int key0 = 32 * (qt + kk) + 16 * s2 + 4 * hh;
                    const LAS unsigned char* v0p = Vtb + r * 520 + key0 * 2, * v1p = v0p + 32 * 520;
                    const v2u x0 = *(const LAS v2u*)(v0p), x1 = *(const LAS v2u*)(v0p + 16), y0 = *(const LAS v2u*)(v1p), y1 = *(const LAS v2u*)(v1p + 16);
                    v4u vw0, vw1; vw0.x = x0.x; vw0.y = x0.y; vw0.z = x1.x; vw0.w = x1.y; vw1.x = y0.x; vw1.y = y0.y; vw1.z = y1.x; vw1.w = y1.y;
                    o0 = __builtin_amdgcn_mfma_f32_32x32x16_bf16(pa, __builtin_bit_cast(bf16x8, vw0), o0, 0, 0, 0);
                    o1 = __builtin_amdgcn_mfma_f32_32x32x16_bf16(pa, __builtin_bit_cast(bf16x8, vw1), o1, 0, 0, 0);
                }
            }
            const float inv = 1.0f / lrun;
#pragma unroll
            for (int e = 0; e < 16; ++e) { const float ie = __shfl(inv, (e & 3) + 8 * (e >> 2) + 4 * hh); o0[e] *= ie; o1[e] *= ie; }
#pragma unroll
            for (int e = 0; e < 16; ++e) {
                const int qr = (e & 3) + 8 * (e >> 2) + 4 * hh;
                bf16* orow = ao + (size_t)(t0 + i0 + qr) * 1024 + head * 64 + r;
                orow[0] = (bf16)f2bf(o0[e]); orow[32] = (bf16)f2bf(o1[e]);
            }
        }
    }
}

__device__ __forceinline__ void final_phase(PTT PT) {
    const int tid = opaque_tid(), lane = tid & 63, wave = tid >> 6;
    const int gw = opaque_bid() * 8 + wave, NGW = gridDim.x * 8;
    const bf16* h = (const bf16*)(WSP + WS_HA); const float* ssq = (const float*)(WSP + WS_SSQ + 7 * 4 * MiB); const float* gf = INP(6);
    f32x4 g[4];
#pragma unroll
    for (int j = 0; j < 2; ++j) { g[2 * j] = *(const f32x4*)(gf + 512 * j + lane * 8); g[2 * j + 1] = *(const f32x4*)(gf + 512 * j + lane * 8 + 4); }
    for (int r = gw; r < T; r += NGW) {
        const float rs = row_rstd(ssq, (size_t)r);
#pragma unroll
        for (int j = 0; j < 2; ++j) {
            const v4u w = *(const v4u*)(h + (size_t)r * D + 512 * j + lane * 8);
            f32x4 o0, o1;
            o0[0] = bflo(w.x) * rs * g[2 * j][0]; o0[1] = bfhi(w.x) * rs * g[2 * j][1]; o0[2] = bflo(w.y) * rs * g[2 * j][2]; o0[3] = bfhi(w.y) * rs * g[2 * j][3];
            o1[0] = bflo(w.z) * rs * g[2 * j + 1][0]; o1[1] = bfhi(w.z) * rs * g[2 * j + 1][1]; o1[2] = bflo(w.w) * rs * g[2 * j + 1][2]; o1[3] = bfhi(w.w) * rs * g[2 * j + 1][3];
            float* op = OUTP + (size_t)r * D + 512 * j + lane * 8;
            *(f32x4*)op = o0; *(f32x4*)(op + 4) = o1;
        }
    }
}

enum { OP_PRO = 0, OP_GEMM = 1, OP_SPATIAL = 2, OP_CONV = 3, OP_ATTN = 4, OP_FINAL = 5 };
constexpr int N_OPS = 24;
__host__ __device__ inline int op_kind(int op) {
    switch (op) { case 0: return OP_PRO; case 2: return OP_SPATIAL; case 5: case 8: case 16: case 19: return OP_CONV; case 13: return OP_ATTN; case 23: return OP_FINAL; default: return OP_GEMM; }
}
__host__ __device__ inline bool op_sync_after(int op) { return !(op == 6 || op == 9 || op == 17 || op == 20 || op == 23); }

__device__ __forceinline__ void make_gemm(int op, PTT PT, pg8::Gemm& g, Epi& E) {
    unsigned char* ws = WSP;
    bf16* HA = (bf16*)(ws + WS_HA); bf16* HB = (bf16*)(ws + WS_HB); bf16* PE = (bf16*)(ws + WS_PE); bf16* BIG = (bf16*)(ws + WS_BIG);
    float* SSQ = (float*)(ws + WS_SSQ); const size_t SS = (size_t)T * 16;
    bf16* ACT = (bf16*)(ws + WS_ACT); bf16* HUP = (bf16*)(ws + WS_HUP);
    E.mode = EM_PLAIN; E.out = nullptr; E.ldo = 1024; E.res = nullptr; E.pe = nullptr; E.ssq_in = nullptr; E.ssq_out = nullptr; E.bias = nullptr; E.out_k = nullptr; E.out_v = nullptr;
    g.A = nullptr; g.Bt = nullptr; g.M = T; g.N = 1024; g.K = 1024;
    const int layer = (op >= 15) ? 1 : 0;
    switch (op) {
        case 1:  g.A = HA; g.Bt = (const bf16*)(ws + WS_WIN); g.N = 2048; E.mode = EM_GELU; E.out = BIG; E.ldo = 2048; E.ssq_in = SSQ; E.ssq_out = SSQ + SS; break;
        case 3:  g.A = BIG + (size_t)T * 2048; g.Bt = (const bf16*)(ws + WS_WOUT); E.mode = EM_RES; E.out = HB; E.res = HA; E.ssq_out = SSQ + 2 * SS; break;
        case 4: case 7: case 15: case 18: {
            const int hf = (op == 7 || op == 18) ? 1 : 0; const bf16* hin = layer ? HA : HB;
            g.A = hin + (size_t)hf * TH * 1024; g.Bt = (const bf16*)(ws + WS_WUP) + (size_t)layer * NUP * 1024; g.M = TH; g.N = NUP;
            E.mode = EM_SCALE; E.out = HUP; E.ldo = NUP; E.ssq_in = SSQ + (layer ? 5 : 2) * SS + (size_t)hf * TH * 16; break; }
        case 6: case 9: case 17: case 20: {
            const int hf = (op == 9 || op == 20) ? 1 : 0; const bf16* hin = layer ? HA : HB; bf16* hout = layer ? HB : HA;
            g.A = ACT; g.Bt = (const bf16*)(ws + WS_WDN) + (size_t)layer * 1024 * DFF; g.M = TH; g.K = DFF;
            E.mode = EM_RES; E.out = hout + (size_t)hf * TH * 1024; E.res = hin + (size_t)hf * TH * 1024; E.ssq_out = SSQ + (layer ? 6 : 3) * SS + (size_t)hf * TH * 16; break; }
        case 10: case 21:
            g.A = (const bf16*)(ws + WS_PB) + (size_t)layer * T * 256; g.Bt = (const bf16*)(ws + WS_WPE) + (size_t)layer * 1024 * 256; g.K = 256; E.mode = EM_PLAIN; E.out = PE; break;
        case 11: case 22: {
            const bf16* hin = layer ? HB : HA; bf16* hout = layer ? HA : HB;
            g.A = hin; g.Bt = (const bf16*)(ws + WS_WG) + (size_t)layer * 1024 * 1024; E.mode = EM_GATE; E.out = hout; E.res = hin; E.pe = PE;
            E.ssq_in = SSQ + (layer ? 6 : 3) * SS; E.ssq_out = SSQ + (layer ? 7 : 4) * SS; E.bias = INP(22) + layer * 1024; break; }
        case 12: g.A = HB; g.Bt = (const bf16*)(ws + WS_WQKV); g.N = 1536; E.mode = EM_QKV; E.out = BIG; E.out_k = BIG + (size_t)T * 1024; E.out_v = BIG + (size_t)T * 1280; E.ssq_in = SSQ + 4 * SS; break;
        case 14: g.A = BIG + (size_t)T * 1536; g.Bt = (const bf16*)(ws + WS_WO); E.mode = EM_RES; E.out = HA; E.res = HB; E.ssq_out = SSQ + 5 * SS; break;
        default: break;
    }
}

__global__ void __launch_bounds__(512, 2) fwd_kernel(Args args) {
    extern __shared__ __attribute__((aligned(16))) unsigned char lds_raw[];
    LAS unsigned char* lds = (LAS unsigned char*)lds_raw;
    cg::grid_group grid = cg::this_grid();
    {
        LAS unsigned long long* PW = (LAS unsigned long long*)(lds + 131072);
        if (threadIdx.x == 0) {
#pragma unroll
            for (int i = 0; i < 23; ++i) PW[i] = (unsigned long long)args.in[i];
            PW[23] = (unsigned long long)args.out; PW[24] = (unsigned long long)args.ws;
        }
        __syncthreads();
    }
    PTT PT = (PTT)(lds + 131072);
    for (int op = args.op_lo; op < args.op_hi; ++op) {
        const int kind = op_kind(op);
        if (kind == OP_GEMM) {
            pg8::Gemm g; Epi E; make_gemm(op, PT, g, E);
            pg8::StaticOrder S; S.init(g.M, g.N, (int)gridDim.x, (int)blockIdx.x);
            pg8::gemm_phase<Epi, pg8::StaticOrder, false>(lds, g, S, E, nullptr);
        } else if (kind == OP_PRO) {
            prologue(PT, lds);
        } else if (kind == OP_SPATIAL) {
            spatial_phase(PT, lds);
        } else if (kind == OP_CONV) {
            const int layer = (op >= 15) ? 1 : 0;
            conv_phase((const bf16*)(WSP + WS_HUP), (bf16*)(WSP + WS_ACT), INP(17) + (size_t)layer * 3 * NUP, INP(18) + (size_t)layer * NUP);
        } else if (kind == OP_ATTN) {
            attn_phase(PT, lds);
        } else {
            final_phase(PT);
        }
        if (op_sync_after(op) && op + 1 < args.op_hi) grid.sync();
        else __syncthreads();
    }
}
}

#ifndef MK_SINGLE
#define MK_SINGLE 1
#endif
#ifndef MK_MAXOP
#define MK_MAXOP N_OPS
#endif
extern "C" void kernel_launch(void* const* d_in, const int* in_sizes, int n_in, void* d_out, int out_size, void* d_ws, size_t ws_size, hipStream_t stream) {
    using namespace mk;
    static int grid = 0;
    if (grid == 0) {
        if (n_in != 23 || ws_size < WS_END) { fprintf(stderr, "kernel_launch: unexpected n_in %d / ws_size %zu\n", n_in, ws_size); grid = -1; return; }
        int dev = 0, cus = 0, per_cu = 0;
        hipGetDevice(&dev); hipDeviceGetAttribute(&cus, hipDeviceAttributeMultiprocessorCount, dev);
        if (hipFuncSetAttribute((const void*)fwd_kernel, hipFuncAttributeMaxDynamicSharedMemorySize, LDS_BYTES) != hipSuccess) { fprintf(stderr, "kernel_launch: hipFuncSetAttribute failed\n"); grid = -1; return; }
        hipOccupancyMaxActiveBlocksPerMultiprocessor(&per_cu, (const void*)fwd_kernel, 512, LDS_BYTES);
        if (per_cu < 1) { fprintf(stderr, "kernel_launch: occupancy query says %d blocks per CU\n", per_cu); per_cu = 1; }
        (void)hipGetLastError();
        grid = cus;
    }
    if (grid < 0) return;
    Args a{};
    for (int i = 0; i < 23; ++i) a.in[i] = (const float*)d_in[i];
    a.out = (float*)d_out; a.ws = (unsigned char*)d_ws;
#if MK_SINGLE
    a.op_lo = 0; a.op_hi = MK_MAXOP;
    void* kargs[] = {&a};
    hipError_t e = hipLaunchCooperativeKernel((const void*)fwd_kernel, dim3(grid), dim3(512), kargs, LDS_BYTES, stream);
    if (e != hipSuccess) fprintf(stderr, "cooperative launch failed: %s (grid %d)\n", hipGetErrorString(e), grid);
#else
    int lo = 0;
    for (int op = 0; op < MK_MAXOP; ++op) {
        if (op_sync_after(op) || op == MK_MAXOP - 1) {
            a.op_lo = lo; a.op_hi = op + 1; lo = op + 1;
            hipLaunchKernelGGL(fwd_kernel, dim3(grid), dim3(512), LDS_BYTES, stream, a);
        }
    }
#endif
}
```

```cpp
#include <hip/hip_runtime.h>
#include <hip/hip_cooperative_groups.h>
#include <cstdio>
namespace cg = cooperative_groups;
namespace pg8 {
#define PG8_LAS __attribute__((address_space(3)))
typedef unsigned short bf16_t;
typedef short bf16x8 __attribute__((ext_vector_type(8)));
typedef float f32x4 __attribute__((ext_vector_type(4)));
typedef unsigned u32x4 __attribute__((ext_vector_type(4)));
constexpr int BM = 256, BK = 64, HALF = 128, HTB = HALF * BK * 2  , STAGE_BYTES = 8 * HTB, NXCD = 8, WGM = 8;

__host__ __device__ __forceinline__ int lds_byte(int r, int c) { const int st = (r >> 4) * 2 + (c >> 5), rr = r & 15, cc = c & 31, ob = rr * 64 + cc * 2; return st * 1024 + (ob ^ (((ob >> 9) & 1) << 5)); }
__host__ __device__ __forceinline__ void stage_rc(int b, int& R, int& C) { const int st = b / 1024, sb = b % 1024, swz = sb ^ (((sb >> 9) & 1) << 5); R = (st >> 1) * 16 + swz / 64; C = (st & 1) * 32 + (swz % 64) / 2; }
__host__ __device__ __forceinline__ int perm32(int rho) { const int n = rho >> 4, i = rho & 15; return 8 * (i >> 2) + 4 * n + (i & 3); }

struct Unit { int pm, pn; };
struct Gemm { const bf16_t* A; const bf16_t* Bt; int M, N, K, aperm; };

struct StaticOrder {
    int nM, nN, nwg, G, c;
    __host__ __device__ void init(int M, int N, int G_, int c_) { nM = M / BM; nN = N / BM; nwg = nM * nN; G = G_; c = c_; }
    __host__ __device__ bool next(int i, Unit& u) const {
        const long L = (long)i * G + c; if (L >= nwg) return false;
        int wgid = (int)L; { const int q = nwg / NXCD, r = nwg % NXCD, xcd = wgid % NXCD, off = wgid / NXCD; wgid = (xcd < r ? xcd * (q + 1) : r * (q + 1) + (xcd - r) * q) + off; }
        const int nig = WGM * nN, gid = wgid / nig, fm = gid * WGM, gsz = (nM - fm) < WGM ? (nM - fm) : WGM;
        u.pm = fm + ((wgid % nig) % gsz); u.pn = (wgid % nig) / gsz; return true;
    }
    __device__ __forceinline__ void a_ready(const Unit&) const {}
    __device__ __forceinline__ void done(const Unit&) const {}
};
__device__ __forceinline__ unsigned cvt_pk_bf16(float lo, float hi) { unsigned r; asm volatile("v_cvt_pk_bf16_f32 %0, %1, %2" : "=v"(r) : "v"(lo), "v"(hi)); return r; }
typedef float f32x2 __attribute__((ext_vector_type(2)));
template <class Epi, class Sched, bool STAMP = false>
__device__ __forceinline__ void gemm_phase(PG8_LAS unsigned char* lds, const Gemm g, const Sched& S, const Epi& E, unsigned long long* stamps) {
    int tid_ = threadIdx.x; asm volatile("" : "+v"(tid_));
    const int tid = tid_, wid = __builtin_amdgcn_readfirstlane(tid >> 6), lane = tid & 63, wr = wid >> 2, wc = wid & 3, fr = lane & 15, fq = lane >> 4;
    const int K = g.K, nt = K / BK;
    int nts = 0;
    if (STAMP && stamps && tid < 64) { stamps[tid] = 0ull; if (tid == 62) stamps[62] = (unsigned long long)wall_clock64(); }
#define PG8_STAMP() do { if (STAMP && stamps && wid == 0 && nts < 62) { const unsigned long long _c = (unsigned long long)clock64(); if (lane == 0) stamps[nts] = _c; ++nts; } } while (0)
    PG8_STAMP();
    unsigned voffA[2], voffB[2];
#pragma unroll
    for (int i = 0; i < 2; ++i) { int R, C; stage_rc(tid * 16 + i * 8192, R, C); const int Rb = Epi::PERM ? ((R & ~31) + perm32(R & 31)) : R;
        const int Ra = g.aperm ? (((R >> 6) << 7) + (R & 63)) : R;
        voffA[i] = (unsigned)(Ra * K + C) * 2u; voffB[i] = (unsigned)(Rb * K + C) * 2u; }
    const size_t kstep = (size_t)(BK * 2);
    const size_t hstep = (size_t)HALF * K * 2;
    const size_t hstepA = g.aperm ? hstep / 2 : hstep;
    const size_t tstep = 2 * hstep;
    const unsigned ldsw = (unsigned)wid * 1024u;
    const int aoff = lds_byte(wr * 64 + fr, fq * 8), boff = lds_byte(wc * 32 + fr, fq * 8);
#define PG8_SA(b, h) (((b) * 2 + (h)) * HTB)
#define PG8_SB(b, h) ((4 + (b) * 2 + (h)) * HTB)
#define PG8_STAGE(bufoff, gbase, voff) do { _Pragma("unroll") for (int _i = 0; _i < 2; ++_i) \
        __builtin_amdgcn_global_load_lds((const unsigned*)((const char*)(gbase) + (voff)[_i]), (PG8_LAS unsigned*)(lds + (bufoff) + ldsw + _i * 8192), 16, 0, 0); } while (0)
#define PG8_LDA(dst, b, h) do { _Pragma("unroll") for (int m = 0; m < 4; ++m) _Pragma("unroll") for (int k = 0; k < 2; ++k) dst[m][k] = *(const PG8_LAS bf16x8*)(lds + PG8_SA(b, h) + aoff + m * 2048 + k * 1024); } while (0)
#define PG8_LDB(dst, b, h) do { _Pragma("unroll") for (int n = 0; n < 2; ++n) _Pragma("unroll") for (int k = 0; k < 2; ++k) dst[n][k] = *(const PG8_LAS bf16x8*)(lds + PG8_SB(b, h) + boff + n * 2048 + k * 1024); } while (0)
#define PG8_MMA(ai, bj, At, Bt) do { __builtin_amdgcn_s_setprio(1); _Pragma("unroll") for (int m = 0; m < 4; ++m) _Pragma("unroll") for (int n = 0; n < 2; ++n) _Pragma("unroll") for (int k = 0; k < 2; ++k) \
        acc[ai][bj][m][n] = __builtin_amdgcn_mfma_f32_16x16x32_bf16(Bt[n][k], At[m][k], acc[ai][bj][m][n], 0, 0, 0); __builtin_amdgcn_s_setprio(0); } while (0)
#define PG8_WAIT_V(n) asm volatile("s_waitcnt vmcnt(" #n ")" ::: "memory")
#define PG8_WAIT_L(n) asm volatile("s_waitcnt lgkmcnt(" #n ")" ::: "memory")
#define PG8_BAR __builtin_amdgcn_s_barrier()
#define PG8_SCHED __builtin_amdgcn_sched_barrier(0)
    Unit cur, nxt; int ui = 0;
    if (!S.next(0, cur)) return;
    f32x4 acc[2][2][4][2];
#pragma unroll
    for (int a = 0; a < 2; ++a)
#pragma unroll
        for (int b = 0; b < 2; ++b)
#pragma unroll
            for (int m = 0; m < 4; ++m)
#pragma unroll
                for (int n = 0; n < 2; ++n) acc[a][b][m][n] = (f32x4){0.f, 0.f, 0.f, 0.f};
    bf16x8 At[4][2], B0[2][2], B1[2][2];
    const char* cA = (const char*)g.A + (size_t)cur.pm * tstep; const char* cB = (const char*)g.Bt + (size_t)cur.pn * tstep;
    S.a_ready(cur);
    PG8_STAGE(PG8_SB(0, 0), cB, voffB); PG8_STAGE(PG8_SA(0, 0), cA, voffA); PG8_STAGE(PG8_SB(0, 1), cB + hstep, voffB); PG8_STAGE(PG8_SA(0, 1), cA + hstepA, voffA);
    if (wr == 1) PG8_BAR;
    PG8_WAIT_V(4); PG8_BAR;
    PG8_STAGE(PG8_SB(1, 0), cB + kstep, voffB); PG8_STAGE(PG8_SA(1, 0), cA + kstep, voffA); PG8_STAGE(PG8_SB(1, 1), cB + hstep + kstep, voffB);
    PG8_WAIT_V(6); PG8_BAR;
    PG8_STAMP();
    for (;;) {
        const bool has_next = S.next(ui + 1, nxt);
        const char* nA = has_next ? (const char*)g.A + (size_t)nxt.pm * tstep : cA; const char* nB = has_next ? (const char*)g.Bt + (size_t)nxt.pn * tstep : cB;
        for (int t = 0; t < nt; t += 2) {
            const bool last = (t == nt - 2);
            const char* a1 = cA + (size_t)(t + 1) * kstep;
            const char* a2 = last ? nA : cA + (size_t)(t + 2) * kstep; const char* b2 = last ? nB : cB + (size_t)(t + 2) * kstep;
            const char* a3 = a2 + kstep; const char* b3 = b2 + kstep;
            if (last && has_next) S.a_ready(nxt);
            PG8_LDB(B0, 0, 0); PG8_SCHED; PG8_LDA(At, 0, 0); PG8_STAGE(PG8_SA(1, 1), a1 + hstepA, voffA);
            PG8_WAIT_L(8); PG8_BAR; PG8_WAIT_L(0); PG8_MMA(0, 0, At, B0); PG8_BAR; PG8_SCHED;
            PG8_LDB(B1, 0, 1); PG8_STAGE(PG8_SB(0, 0), b2, voffB);
            PG8_BAR; PG8_WAIT_L(0); PG8_MMA(0, 1, At, B1); PG8_BAR;
            PG8_LDA(At, 0, 1); PG8_STAGE(PG8_SA(0, 0), a2, voffA);
            PG8_BAR; PG8_WAIT_L(0); PG8_MMA(1, 0, At, B0); PG8_BAR; PG8_SCHED;
            PG8_STAGE(PG8_SB(0, 1), b2 + hstep, voffB);
            PG8_WAIT_V(6); PG8_BAR; PG8_MMA(1, 1, At, B1); PG8_BAR;
            PG8_LDB(B0, 1, 0); PG8_SCHED; PG8_LDA(At, 1, 0); PG8_STAGE(PG8_SA(0, 1), a2 + hstepA, voffA);
            PG8_WAIT_L(8); PG8_BAR; PG8_WAIT_L(0); PG8_MMA(0, 0, At, B0); PG8_BAR; PG8_SCHED;
            PG8_LDB(B1, 1, 1); PG8_STAGE(PG8_SB(1, 0), b3, voffB);
            PG8_BAR; PG8_WAIT_L(0); PG8_MMA(0, 1, At, B1); PG8_BAR;
            PG8_LDA(At, 1, 1); PG8_STAGE(PG8_SA(1, 0), a3, voffA);
            PG8_BAR; PG8_WAIT_L(0); PG8_MMA(1, 0, At, B0); PG8_BAR; PG8_SCHED;
            PG8_STAGE(PG8_SB(1, 1), b3 + hstep, voffB);
            PG8_WAIT_V(6); PG8_BAR; PG8_MMA(1, 1, At, B1); PG8_BAR;
        }
        PG8_STAMP();
        if constexpr (!Epi::AFTER_DRAIN) { E(acc, cur, wr, wc, fr, fq); S.done(cur); }
        PG8_STAMP();
        if (!has_next) break;
#pragma unroll
        for (int a = 0; a < 2; ++a)
#pragma unroll
            for (int b = 0; b < 2; ++b)
#pragma unroll
                for (int m = 0; m < 4; ++m)
#pragma unroll
                    for (int n = 0; n < 2; ++n) acc[a][b][m][n] = (f32x4){0.f, 0.f, 0.f, 0.f};
        cur = nxt; cA = nA; cB = nB; ++ui;
    }
    PG8_WAIT_V(0);
    if (wr == 0) PG8_BAR;
    PG8_BAR;
    if constexpr (Epi::AFTER_DRAIN) { E.fused(acc, cur, wr, wc, fr, fq, lds, wid, lane); S.done(cur); }
    PG8_STAMP();
    if (STAMP && stamps && tid == 0) stamps[63] = (unsigned long long)wall_clock64();
#undef PG8_STAMP
#undef PG8_SA
#undef PG8_SB
#undef PG8_STAGE
#undef PG8_LDA
#undef PG8_LDB
#undef PG8_MMA
#undef PG8_WAIT_V
#undef PG8_WAIT_L
#undef PG8_BAR
#undef PG8_SCHED
}
}

namespace mk {
using pg8::bf16x8; using pg8::f32x4; using pg8::Unit;
#define LAS __attribute__((address_space(3)))
#define GAS __attribute__((address_space(1)))
typedef unsigned short bf16;
typedef unsigned v4u __attribute__((ext_vector_type(4)));
typedef unsigned v2u __attribute__((ext_vector_type(2)));
typedef float f32x16 __attribute__((ext_vector_type(16)));
typedef float f32x2_t __attribute__((ext_vector_type(2)));
typedef __bf16 bf16x2_t __attribute__((ext_vector_type(2)));

constexpr int T = 65536, D = 1024, SEQ = 8192, DFF = 2816, NUP = 5632, TH = 32768  ;
constexpr float EPS = 1e-6f;
constexpr size_t MiB = (size_t)1 << 20;
constexpr size_t WS_WIN = 1 * MiB, WS_WOUT = 5 * MiB, WS_WQKV = 7 * MiB, WS_WO = 10 * MiB, WS_WUP = 12 * MiB, WS_WDN = 34 * MiB, WS_WPE = 45 * MiB, WS_WG = 46 * MiB, WS_WS = 50 * MiB;
constexpr size_t WS_SSQ = 56 * MiB;
constexpr size_t WS_PB = 88 * MiB;
constexpr size_t WS_HA = 152 * MiB, WS_HB = 280 * MiB;
constexpr size_t WS_PE = 808 * MiB;
constexpr size_t WS_BIG = 536 * MiB;
constexpr size_t WS_ACT = 408 * MiB;
constexpr size_t WS_RAW = 760 * MiB;
constexpr size_t WS_END = 1024 * MiB;
constexpr int LDS_BYTES = 147456;
constexpr size_t WS_BAR = 64 * 1024, WS_BAR_BYTES = 16 * 1024;

#ifndef MK_DIAG
#define MK_DIAG 0
#endif
#ifndef MK_DIAG_OP
#define MK_DIAG_OP 4
#endif
#ifndef MK_DIAG_MODE
#define MK_DIAG_MODE 0
#endif
#ifndef MK_DIAG_OP2
#define MK_DIAG_OP2 6
#endif
#ifndef MK_REP_MASK
#define MK_REP_MASK 0u
#endif
#ifndef MK_REP_NOEPI
#define MK_REP_NOEPI 0
#endif
struct Args {
    const float* in[23]; float* out; unsigned char* ws; int op_lo, op_hi;
};
typedef LAS const unsigned long long* PTT;
__device__ __forceinline__ unsigned long long ldp(PTT PT, int i) {
    asm volatile("" ::: "memory");
    const unsigned long long v = PT[i];
    const unsigned lo = __builtin_amdgcn_readfirstlane((unsigned)v), hi = __builtin_amdgcn_readfirstlane((unsigned)(v >> 32));
    return ((unsigned long long)hi << 32) | lo;
}
#define INP(i) ((const GAS float*)ldp(PT, (i)))
#define OUTP ((GAS float*)ldp(PT, 23))
#define WSP ((GAS unsigned char*)ldp(PT, 24))

__device__ __forceinline__ int opaque_tid() { int t = threadIdx.x; asm volatile("" : "+v"(t)); return t; }
__device__ __forceinline__ int opaque_bid() { int b = blockIdx.x; asm volatile("" : "+s"(b)); return b; }
__device__ __forceinline__ unsigned f2bf(float f) { unsigned u = __builtin_bit_cast(unsigned, f); return (u + 0x7fffu + ((u >> 16) & 1u)) >> 16; }
__device__ __forceinline__ unsigned pk2(float lo, float hi) { f32x2_t v = {lo, hi}; bf16x2_t b = __builtin_convertvector(v, bf16x2_t); return __builtin_bit_cast(unsigned, b); }
__device__ __forceinline__ float bflo(unsigned w) { return __builtin_bit_cast(float, w << 16); }
__device__ __forceinline__ float bfhi(unsigned w) { return __builtin_bit_cast(float, w & 0xffff0000u); }
__device__ __forceinline__ float bf2f(bf16 b) { return __builtin_bit_cast(float, ((unsigned)b) << 16); }
__device__ __forceinline__ float fast_sigmoid(float x) { return __builtin_amdgcn_rcpf(1.0f + __expf(-x)); }
__device__ __forceinline__ float gelu_tanh(float x) { const float y = x * (1.5957691216f + 0.0713548163f * x * x); return x * __builtin_amdgcn_rcpf(1.0f + __expf(-y)); }
__device__ __forceinline__ float row_rstd(const GAS float* ssq, size_t row) {
    const f32x4 a = *(const GAS f32x4*)(ssq + (row) * 4), b = *(const GAS f32x4*)(ssq + ((size_t)T + row) * 4), c = *(const GAS f32x4*)(ssq + ((size_t)2 * T + row) * 4), d = *(const GAS f32x4*)(ssq + ((size_t)3 * T + row) * 4);
    const float s = ((a[0] + a[1]) + (a[2] + a[3])) + ((b[0] + b[1]) + (b[2] + b[3])) + ((c[0] + c[1]) + (c[2] + c[3])) + ((d[0] + d[1]) + (d[2] + d[3]));
    return rsqrtf(s * (1.0f / 1024.0f) + EPS);
}
__device__ __forceinline__ float wave_sum(float v) {
#pragma unroll
    for (int o = 1; o < 64; o <<= 1) v += __shfl_xor(v, o);
    return v;
}

template <bool APERM> __device__ __forceinline__ void wave_rstd8(const GAS float* ssq, int rowbase, int fq, float (&rs)[8]) {
    f32x4 v[8];
#pragma unroll
    for (int q = 0; q < 8; ++q) { const int row = rowbase + (APERM ? 16 * q : (q >> 2) * 128 + (q & 3) * 16); v[q] = *(const GAS f32x4*)(ssq + ((size_t)fq * T + (size_t)row) * 4); }
#pragma unroll
    for (int q = 0; q < 8; ++q) { float t = (v[q][0] + v[q][1]) + (v[q][2] + v[q][3]); t += __shfl_xor(t, 16); t += __shfl_xor(t, 32); rs[q] = rsqrtf(t * (1.0f / 1024.0f) + EPS); }
}

enum { EM_PLAIN = 0, EM_GELU = 1, EM_RES = 2, EM_SCALE = 3, EM_GATE = 4, EM_QKV = 5, EM_UPCONV = 6 };
__device__ __forceinline__ float dpp_ror1(float x) { return __builtin_bit_cast(float, __builtin_amdgcn_mov_dpp(__builtin_bit_cast(int, x), 0x121, 0xf, 0xf, false)); }
__device__ __forceinline__ float dpp_ror2(float x) { return __builtin_bit_cast(float, __builtin_amdgcn_mov_dpp(__builtin_bit_cast(int, x), 0x122, 0xf, 0xf, false)); }
struct Epi {
    static constexpr bool PERM = true, AFTER_DRAIN = false;
    int mode; GAS bf16* out; int ldo; const GAS bf16* res; const GAS bf16* pe; const GAS float* ssq_in; GAS float* ssq_out; const GAS float* bias; GAS bf16* out_k; GAS bf16* out_v; const GAS float* cw; int skip; LAS float* par;
    __device__ __forceinline__ void upconv(f32x4 (&acc)[2][2][4][2], const Unit& u, int wr, int wc, int fr, int fq) const {
        const int tok0 = u.pm * 256 + wr * 128, jc = u.pn * 128 + wc * 32 + 8 * fq, lane = fq * 16 + fr, wid = wr * 4 + wc;
        const int pa = lane >> 3, pc = 4 * (lane & 7);
        const GAS float* psrc = ((pa < 6) ? cw + (pa % 3) * NUP + ((pa >= 3) ? DFF : 0) : bias + ((pa == 7) ? DFF : 0)) + u.pn * 128 + wc * 32 + pc;
        const f32x4 pv = *(const GAS f32x4*)psrc;
        float rs[8]; wave_rstd8<true>(ssq_in, tok0 + fr, fq, rs);
        LAS float* P = par + wid * 256;
        *(LAS f32x4*)(P + pa * 32 + pc) = pv;
#pragma unroll
        for (int q = 0; q < 8; ++q) { acc[q >> 2][0][q & 3][0] *= rs[q]; acc[q >> 2][0][q & 3][1] *= rs[q]; acc[q >> 2][1][q & 3][0] *= rs[q]; acc[q >> 2][1][q & 3][1] *= rs[q]; }
        GAS float* rawg = ssq_out + (size_t)(2 * u.pm + wr) * 4 * NUP + jc;
        GAS float* dumw = (GAS float*)out_k + (size_t)(blockIdx.x * 8 + wid) * 32;
        { GAS float* pg = (fr < 2) ? rawg + fr * NUP : dumw; GAS float* pu = (fr < 2) ? pg + DFF : dumw + 16;
          *(GAS f32x4*)pg = acc[0][0][0][0]; *(GAS f32x4*)(pg + 4) = acc[0][0][0][1]; *(GAS f32x4*)pu = acc[0][1][0][0]; *(GAS f32x4*)(pu + 4) = acc[0][1][0][1]; }
        { GAS float* pg = (fr >= 14) ? rawg + (fr - 12) * NUP : dumw; GAS float* pu = (fr >= 14) ? pg + DFF : dumw + 16;
          *(GAS f32x4*)pg = acc[1][0][3][0]; *(GAS f32x4*)(pg + 4) = acc[1][0][3][1]; *(GAS f32x4*)pu = acc[1][1][3][0]; *(GAS f32x4*)(pu + 4) = acc[1][1][3][1]; }
        asm volatile("" ::: "memory");
        const bool f1 = fr >= 1, f2 = fr >= 2;
#pragma unroll
        for (int n = 0; n < 2; ++n) {
            unsigned ow[8][2];
#pragma unroll
            for (int kp = 0; kp < 2; ++kp) {
                const LAS float* Pc = P + 8 * fq + 4 * n + 2 * kp;
                const f32x2_t wg0 = *(const LAS f32x2_t*)(Pc), wg1 = *(const LAS f32x2_t*)(Pc + 32), wg2 = *(const LAS f32x2_t*)(Pc + 64);
                const f32x2_t wu0 = *(const LAS f32x2_t*)(Pc + 96), wu1 = *(const LAS f32x2_t*)(Pc + 128), wu2 = *(const LAS f32x2_t*)(Pc + 160);
                const f32x2_t bg = *(const LAS f32x2_t*)(Pc + 192), bu = *(const LAS f32x2_t*)(Pc + 224);
                float r0[8];
#pragma unroll
                for (int kk = 0; kk < 2; ++kk) {
                    const int k = 2 * kp + kk;
                    float g1p = 0.f, g2p = 0.f, u1p = 0.f, u2p = 0.f;
#pragma unroll
                    for (int q = 0; q < 8; ++q) {
                        const float g = acc[q >> 2][0][q & 3][n][k], uu = acc[q >> 2][1][q & 3][n][k];
                        const float g1 = dpp_ror1(g), g2 = dpp_ror2(g), u1 = dpp_ror1(uu), u2 = dpp_ror2(uu);
                        const float pg1 = f1 ? g1 : g1p, pg2 = f2 ? g2 : g2p, pu1 = f1 ? u1 : u1p, pu2 = f2 ? u2 : u2p;
                        const float cg = bg[kk] + wg0[kk] * pg2 + wg1[kk] * pg1 + wg2[kk] * g;
                        const float cu = bu[kk] + wu0[kk] * pu2 + wu1[kk] * pu1 + wu2[kk] * uu;
                        const float res = cg * fast_sigmoid(cg) * cu;
                        if (kk == 0) r0[q] = res; else ow[q][kp] = pk2(r0[q], res);
                        g1p = g1; g2p = g2; u1p = u1; u2p = u2;
                    }
                }
                asm volatile("" ::: "memory");
            }
#pragma unroll
            for (int q = 0; q < 8; ++q) { v2u w; w.x = ow[q][0]; w.y = ow[q][1]; *(GAS v2u*)(out + (size_t)(tok0 + 16 * q + fr) * DFF + jc + 4 * n) = w; }
            asm volatile("" ::: "memory");
        }
    }
    __device__ __forceinline__ void operator()(f32x4 (&acc)[2][2][4][2], const Unit& u, int wr, int wc, int fr, int fq) const {
        if (MK_REP_MASK != 0u && skip) return;
        if (mode == EM_UPCONV) { upconv(acc, u, wr, wc, fr, fq); return; }
        const int row0 = u.pm * 256 + wr * 64 + fr;
        const int colt = u.pn * 256, cw = wc * 32 + 8 * fq;
        GAS bf16* obase = out; int old = ldo, ocol = colt;
        if (mode == EM_QKV) { if (u.pn == 4) { obase = out_k; old = 256; ocol = 0; } else if (u.pn == 5) { obase = out_v; old = 256; ocol = 0; } }
        const bool use_rs = (mode == EM_GELU) | (mode == EM_SCALE) | (mode == EM_GATE) | (mode == EM_QKV);
        const bool do_ssq = (mode == EM_RES) | (mode == EM_GATE) | ((mode == EM_GELU) & (u.pn >= 4));
        const unsigned slotbase = (unsigned)((mode == EM_GELU) ? (u.pn - 4) : u.pn) * (unsigned)T;
        float rsv[8];
        if (use_rs) wave_rstd8<false>(ssq_in, row0, fq, rsv);
        else {
#pragma unroll
            for (int q = 0; q < 8; ++q) rsv[q] = 1.0f; }
        LAS float* Pb = par + (wr * 4 + wc) * 256;
        if (mode == EM_GATE) {
            const int l16 = fq * 16 + fr;
            if (l16 < 16) *(LAS f32x4*)(Pb + (l16 >> 3) * 32 + 4 * (l16 & 7)) = *(const GAS f32x4*)(bias + colt + (l16 >> 3) * 128 + wc * 32 + 4 * (l16 & 7));
        }
#pragma unroll
        for (int aq = 0; aq < 4; ++aq) {
            const int ai = aq >> 1, m0 = (aq & 1) * 2;
            v4u rr[2][2], ee[2][2];
            if ((mode == EM_RES) | (mode == EM_GATE)) {
#pragma unroll
                for (int mm = 0; mm < 2; ++mm)
#pragma unroll
                    for (int bj = 0; bj < 2; ++bj) rr[mm][bj] = *(const GAS v4u*)(res + ((unsigned)(row0 + ai * 128 + (m0 + mm) * 16) * 1024u + (unsigned)(colt + bj * 128 + cw)));
            }
            if (mode == EM_GATE) {
#pragma unroll
                for (int mm = 0; mm < 2; ++mm)
#pragma unroll
                    for (int bj = 0; bj < 2; ++bj) ee[mm][bj] = *(const GAS v4u*)(pe + ((unsigned)(row0 + ai * 128 + (m0 + mm) * 16) * 1024u + (unsigned)(colt + bj * 128 + cw)));
            }
            __builtin_amdgcn_sched_barrier(0);
#pragma unroll
            for (int mm = 0; mm < 2; ++mm) {
                const int m = m0 + mm;
                const unsigned row = (unsigned)(row0 + ai * 128 + m * 16);
                const float rs = rsv[ai * 4 + m];
                float sq = 0.f;
#pragma unroll
                for (int bj = 0; bj < 2; ++bj) {
                    f32x4 v0 = acc[ai][bj][m][0] * rs, v1 = acc[ai][bj][m][1] * rs;
                    if (mode == EM_GELU) {
#pragma unroll
                        for (int j = 0; j < 4; ++j) { v0[j] = gelu_tanh(v0[j]); v1[j] = gelu_tanh(v1[j]); }
                    } else if (mode == EM_RES) {
                        const v4u r = rr[mm][bj];
                        v0[0] += bflo(r.x); v0[1] += bfhi(r.x); v0[2] += bflo(r.y); v0[3] += bfhi(r.y);
                        v1[0] += bflo(r.z); v1[1] += bfhi(r.z); v1[2] += bflo(r.w); v1[3] += bfhi(r.w);
                    } else if (mode == EM_GATE) {
                        const v4u r = rr[mm][bj], e = ee[mm][bj];
                        const f32x4 b0 = *(const LAS f32x4*)(Pb + bj * 32 + 8 * fq), b1 = *(const LAS f32x4*)(Pb + bj * 32 + 8 * fq + 4);
                        v0[0] = bflo(r.x) + bflo(e.x) * fast_sigmoid(v0[0] + b0[0]); v0[1] = bfhi(r.x) + bfhi(e.x) * fast_sigmoid(v0[1] + b0[1]);
                        v0[2] = bflo(r.y) + bflo(e.y) * fast_sigmoid(v0[2] + b0[2]); v0[3] = bfhi(r.y) + bfhi(e.y) * fast_sigmoid(v0[3] + b0[3]);
                        v1[0] = bflo(r.z) + bflo(e.z) * fast_sigmoid(v1[0] + b1[0]); v1[1] = bfhi(r.z) + bfhi(e.z) * fast_sigmoid(v1[1] + b1[1]);
                        v1[2] = bflo(r.w) + bflo(e.w) * fast_sigmoid(v1[2] + b1[2]); v1[3] = bfhi(r.w) + bfhi(e.w) * fast_sigmoid(v1[3] + b1[3]);
                    }
                    sq += (v0[0] * v0[0] + v0[1] * v0[1]) + (v0[2] * v0[2] + v0[3] * v0[3]) + (v1[0] * v1[0] + v1[1] * v1[1]) + (v1[2] * v1[2] + v1[3] * v1[3]);
                    v4u w; w.x = pk2(v0[0], v0[1]); w.y = pk2(v0[2], v0[3]); w.z = pk2(v1[0], v1[1]); w.w = pk2(v1[2], v1[3]);
                    *(GAS v4u*)(obase + (row * (unsigned)old + (unsigned)(ocol + bj * 128 + cw))) = w;
                }
                if (do_ssq) {
                    sq += __shfl_xor(sq, 16); sq += __shfl_xor(sq, 32);
                    if (fq == 0) ssq_out[(slotbase + row) * 4u + (unsigned)wc] = sq;
                }
            }
            __builtin_amdgcn_sched_barrier(0);
        }
    }
};

__device__ __forceinline__ void transpose_item(const GAS float* W, int K, int N, GAS bf16* WT, int row_off, const GAS float* gain, LAS float* scr, int item, int lane, bool upperm) {
    const int nblk = N / 32, kb = item / nblk, nb = item % nblk, k0 = 64 * kb, n0 = 32 * nb;
    int r0 = row_off + n0;
    if (upperm) { const int bj = (n0 >= DFF) ? 1 : 0, ci = n0 - DFF * bj; r0 = 256 * (ci >> 7) + 128 * bj + (ci & 127); }
#pragma unroll 16
    for (int i = 0; i < 32; ++i) { const int kk = 2 * i + (lane >> 5); const float gsc = gain ? gain[k0 + kk] : 1.0f; scr[kk * 33 + (lane & 31)] = W[(size_t)(k0 + kk) * N + n0 + (lane & 31)] * gsc; }
    asm volatile("s_waitcnt lgkmcnt(0)" ::: "memory");
    const int c = lane & 7;
#pragma unroll
    for (int j = 0; j < 4; ++j) { const int n = (lane >> 3) + 8 * j; const LAS float* s = scr + (8 * c) * 33 + n;
        v4u o; o.x = pk2(s[0 * 33], s[1 * 33]); o.y = pk2(s[2 * 33], s[3 * 33]); o.z = pk2(s[4 * 33], s[5 * 33]); o.w = pk2(s[6 * 33], s[7 * 33]);
        *(GAS v4u*)(WT + (size_t)(r0 + n) * K + k0 + 8 * c) = o; }
    asm volatile("s_waitcnt lgkmcnt(0)" ::: "memory");
}

__device__ __forceinline__ void prologue(PTT PT, LAS unsigned char* lds) {
    const int tid = opaque_tid(), bid = opaque_bid(), lane = tid & 63, wave = tid >> 6;
    const int gw = bid * 8 + wave, NGW = gridDim.x * 8;
    LAS float* scr = (LAS float*)(lds + wave * 16384);
    GAS unsigned char* ws = WSP;
    {
        const int tw = gw, NTW = NGW;
        for (int gi = tw; gi < 12544; gi += NTW) {
            const GAS float* W; int K, N, ro = 0, it = gi, mi; GAS bf16* WT; const GAS float* gain = nullptr;
            if (gi < 1024) { mi = 0; W = INP(7); K = 1024; N = 2048; WT = (GAS bf16*)(ws + WS_WIN); gain = INP(2); }
            else if (gi < 1536) { mi = 1; it = gi - 1024; W = INP(11); K = 1024; N = 1024; WT = (GAS bf16*)(ws + WS_WOUT); }
            else if (gi < 2048) { mi = 2; it = gi - 1536; W = INP(13); K = 1024; N = 1024; WT = (GAS bf16*)(ws + WS_WQKV); gain = INP(2) + 1024; }
            else if (gi < 2304) { mi = 3; it = gi - 2048; W = INP(12); K = 1024; N = 512; WT = (GAS bf16*)(ws + WS_WQKV); ro = 1024; gain = INP(5); }
            else if (gi < 2816) { mi = 4; it = gi - 2304; W = INP(15); K = 1024; N = 1024; WT = (GAS bf16*)(ws + WS_WO); }
            else if (gi < 5632) { mi = 5; it = gi - 2816; W = INP(16); K = 1024; N = NUP; WT = (GAS bf16*)(ws + WS_WUP); gain = INP(3); }
            else if (gi < 8448) { mi = 6; it = gi - 5632; W = INP(16) + (size_t)1024 * NUP; K = 1024; N = NUP; WT = (GAS bf16*)(ws + WS_WUP) + (size_t)NUP * 1024; gain = INP(3) + 1024; }
            else if (gi < 9856) { mi = 7; it = gi - 8448; W = INP(19); K = DFF; N = 1024; WT = (GAS bf16*)(ws + WS_WDN); }
            else if (gi < 11264) { mi = 8; it = gi - 9856; W = INP(19) + (size_t)DFF * 1024; K = DFF; N = 1024; WT = (GAS bf16*)(ws + WS_WDN) + (size_t)1024 * DFF; }
            else if (gi < 11392) { mi = 9; it = gi - 11264; W = INP(20); K = 256; N = 1024; WT = (GAS bf16*)(ws + WS_WPE); }
            else if (gi < 11520) { mi = 10; it = gi - 11392; W = INP(20) + (size_t)256 * 1024; K = 256; N = 1024; WT = (GAS bf16*)(ws + WS_WPE) + (size_t)1024 * 256; }
            else if (gi < 12032) { mi = 11; it = gi - 11520; W = INP(21); K = 1024; N = 1024; WT = (GAS bf16*)(ws + WS_WG); gain = INP(4); }
            else { mi = 12; it = gi - 12032; W = INP(21) + (size_t)1024 * 1024; K = 1024; N = 1024; WT = (GAS bf16*)(ws + WS_WG) + (size_t)1024 * 1024; gain = INP(4) + 1024; }
            transpose_item(W, K, N, WT, ro, gain, scr, it, lane, mi == 5 || mi == 6);
        }
    }
    {
        const GAS float* w = INP(9); GAS bf16* o = (GAS bf16*)(ws + WS_WS);
        for (int i = bid * 512 + tid; i < 8 * 128 * 128; i += gridDim.x * 512) { const int s = i & 127, t = (i >> 7) & 127; o[i] = (bf16)f2bf(s <= t ? w[i] : 0.0f); }
    }
    {
        const GAS float* x = INP(0); GAS bf16* xb = (GAS bf16*)(ws + WS_HA); GAS float* ssq0 = (GAS float*)(ws + WS_SSQ);
#pragma unroll 8
        for (int r = gw; r < T; r += NGW) {
            const GAS f32x4* xr = (const GAS f32x4*)(x + (size_t)r * D) + lane; float s = 0.f;
            GAS unsigned long long* o8 = (GAS unsigned long long*)(xb + (size_t)r * D) + lane;
#pragma unroll
            for (int j = 0; j < 4; ++j) { const f32x4 v = xr[64 * j]; s += (v[0] * v[0] + v[1] * v[1]) + (v[2] * v[2] + v[3] * v[3]);
                o8[64 * j] = (unsigned long long)pk2(v[0], v[1]) | ((unsigned long long)pk2(v[2], v[3]) << 32); }
            s = wave_sum(s);
            if (lane < 16) ssq0[((size_t)(lane >> 2) * T + (size_t)r) * 4 + (lane & 3)] = (lane == 0) ? s : 0.f;
        }
    }
    {
        const GAS f32x4* p4 = (const GAS f32x4*)INP(1); GAS unsigned long long* o8 = (GAS unsigned long long*)(ws + WS_PB);
        const size_t n4 = (size_t)2 * T * 256 / 4;
#pragma unroll 8
        for (size_t i = (size_t)bid * 512 + tid; i < n4; i += (size_t)gridDim.x * 512) { const f32x4 v = p4[i]; o8[i] = (unsigned long long)pk2(v[0], v[1]) | ((unsigned long long)pk2(v[2], v[3]) << 32); }
    }
}

__device__ __forceinline__ void spatial_phase(PTT PT, LAS unsigned char* lds) {
    const int tid = opaque_tid(), bid = opaque_bid(), lane = tid & 63, wave = __builtin_amdgcn_readfirstlane(tid >> 6), r = lane & 31, hh = lane >> 5;
    GAS unsigned char* ws = WSP;
    const GAS bf16* z = (const GAS bf16*)(ws + WS_BIG); GAS bf16* us = (GAS bf16*)(ws + WS_BIG + 256 * MiB);
    const GAS float* ssq1 = (const GAS float*)(ws + WS_SSQ + 1 * 4 * MiB);
    const GAS bf16* Wsb = (const GAS bf16*)(ws + WS_WS);
    const GAS float* gv = INP(8); const GAS float* bs = INP(10);
    LAS unsigned* vT32 = (LAS unsigned*)lds;
    LAS unsigned char* vTb = lds;
    const int tt = wave >> 1, dd0 = (wave & 1) * 2, p = tid & 63;
    int hcur = -1; bf16x8 af[8]; float biasv[16]; f32x4 gg[2][2];
    v4u nva[2], nvb[2]; float nrsa = 0.f, nrsb = 0.f;
#define SP_FETCH(UU) do { const int h_ = (UU) & 7, c_ = (UU) >> 3; const size_t ra_ = (size_t)c_ * 128 + 2 * p, rb_ = ra_ + 1; \
        nrsa = row_rstd(ssq1, ra_); nrsb = row_rstd(ssq1, rb_); \
        _Pragma("unroll") for (int it = 0; it < 2; ++it) { const int cc = (tid >> 6) + 8 * it; \
            nva[it] = *(const GAS v4u*)(z + ra_ * 2048 + 1024 + h_ * 128 + cc * 8); nvb[it] = *(const GAS v4u*)(z + rb_ * 2048 + 1024 + h_ * 128 + cc * 8); } } while (0)
    if (bid < 4096) SP_FETCH(bid);
    for (int u = bid; u < 4096; u += gridDim.x) {
        const int h = u & 7, c = u >> 3; const size_t tok0 = (size_t)c * 128;
        if (h != hcur) {
            hcur = h;
            const GAS bf16* wrow = Wsb + ((size_t)(h * 128 + 32 * tt + r)) * 128 + 8 * hh;
#pragma unroll
            for (int ks = 0; ks < 8; ++ks) af[ks] = *(const GAS bf16x8*)(wrow + 16 * ks);
#pragma unroll
            for (int reg = 0; reg < 16; ++reg) biasv[reg] = bs[h * 128 + 32 * tt + (reg & 3) + 8 * (reg >> 2) + 4 * hh];
#pragma unroll
            for (int it = 0; it < 2; ++it) { const int cc = (tid >> 6) + 8 * it; gg[it][0] = *(const GAS f32x4*)(gv + h * 128 + cc * 8); gg[it][1] = *(const GAS f32x4*)(gv + h * 128 + cc * 8 + 4); }
        }
        __syncthreads();
#pragma unroll
        for (int it = 0; it < 2; ++it) {
            const int cc = (tid >> 6) + 8 * it;
            const v4u va = nva[it], vb = nvb[it]; const f32x4 g0 = gg[it][0], g1 = gg[it][1]; const float rsa = nrsa, rsb = nrsb;
            LAS unsigned* dst = vT32 + (cc * 8) * 68 + p;
            dst[0 * 68] = pk2(bflo(va.x) * rsa * g0[0], bflo(vb.x) * rsb * g0[0]);
            dst[1 * 68] = pk2(bfhi(va.x) * rsa * g0[1], bfhi(vb.x) * rsb * g0[1]);
            dst[2 * 68] = pk2(bflo(va.y) * rsa * g0[2], bflo(vb.y) * rsb * g0[2]);
            dst[3 * 68] = pk2(bfhi(va.y) * rsa * g0[3], bfhi(vb.y) * rsb * g0[3]);
            dst[4 * 68] = pk2(bflo(va.z) * rsa * g1[0], bflo(vb.z) * rsb * g1[0]);
            dst[5 * 68] = pk2(bfhi(va.z) * rsa * g1[1], bfhi(vb.z) * rsb * g1[1]);
            dst[6 * 68] = pk2(bflo(va.w) * rsa * g1[2], bflo(vb.w) * rsb * g1[2]);
            dst[7 * 68] = pk2(bfhi(va.w) * rsa * g1[3], bfhi(vb.w) * rsb * g1[3]);
        }
        __syncthreads();
        if (u + (int)gridDim.x < 4096) SP_FETCH(u + (int)gridDim.x);
        bf16 uv0[16], uv1[16];
#pragma unroll
        for (int reg = 0; reg < 16; ++reg) { const size_t tok = tok0 + 32 * tt + (reg & 3) + 8 * (reg >> 2) + 4 * hh; const int ch = h * 128 + 32 * dd0 + r;
            uv0[reg] = z[tok * 2048 + ch]; uv1[reg] = z[tok * 2048 + ch + 32]; }
        f32x16 acc0, acc1;
#pragma unroll
        for (int i = 0; i < 16; ++i) { acc0[i] = 0.f; acc1[i] = 0.f; }
        const LAS unsigned char* b0p = vTb + (32 * dd0 + r) * 272 + 16 * hh, * b1p = b0p + 32 * 272;
        const int nks = 2 * tt + 2;
#pragma unroll
        for (int ks = 0; ks < 8; ++ks) {
            if (ks < nks) {
                const bf16x8 bf0 = *(const LAS bf16x8*)(b0p + 32 * ks), bf1 = *(const LAS bf16x8*)(b1p + 32 * ks);
                acc0 = __builtin_amdgcn_mfma_f32_32x32x16_bf16(af[ks], bf0, acc0, 0, 0, 0);
                acc1 = __builtin_amdgcn_mfma_f32_32x32x16_bf16(af[ks], bf1, acc1, 0, 0, 0);
            }
        }
#pragma unroll
        for (int reg = 0; reg < 16; ++reg) {
            const int t = 32 * tt + (reg & 3) + 8 * (reg >> 2) + 4 * hh;
            const size_t tok = tok0 + t; const int ch = h * 128 + 32 * dd0 + r;
            const float u0 = bf2f(uv0[reg]), u1 = bf2f(uv1[reg]);
            us[tok * 1024 + ch] = (bf16)f2bf(u0 * (acc0[reg] + biasv[reg]));
            us[tok * 1024 + ch + 32] = (bf16)f2bf(u1 * (acc1[reg] + biasv[reg]));
        }
    }
#undef SP_FETCH
}

__device__ __forceinline__ void fix_phase(const GAS float* raw, GAS bf16* act, const GAS float* cw, const GAS float* cb) {
    constexpr int NC4 = DFF / 4;
    const int nitems = 512 * NC4;
    for (int it = opaque_bid() * 512 + opaque_tid(); it < nitems; it += gridDim.x * 512) {
        const int grp = it / NC4, c4 = (it % NC4) * 4;
        const f32x4 wg0 = *(const GAS f32x4*)(cw + c4), wg1 = *(const GAS f32x4*)(cw + NUP + c4), wg2 = *(const GAS f32x4*)(cw + 2 * NUP + c4);
        const f32x4 wu0 = *(const GAS f32x4*)(cw + DFF + c4), wu1 = *(const GAS f32x4*)(cw + NUP + DFF + c4), wu2 = *(const GAS f32x4*)(cw + 2 * NUP + DFF + c4);
        const f32x4 bg = *(const GAS f32x4*)(cb + c4), bu = *(const GAS f32x4*)(cb + DFF + c4);
        const GAS float* rc = raw + (size_t)grp * 4 * NUP + c4;
        const f32x4 g0 = *(const GAS f32x4*)(rc), u0 = *(const GAS f32x4*)(rc + DFF), g1 = *(const GAS f32x4*)(rc + NUP), u1 = *(const GAS f32x4*)(rc + NUP + DFF);
        f32x4 gm2 = {0.f, 0.f, 0.f, 0.f}, gm1 = gm2, um2 = gm2, um1 = gm2;
        if ((grp & 63) != 0) { const GAS float* rp = rc - 4 * NUP; gm2 = *(const GAS f32x4*)(rp + 2 * NUP); um2 = *(const GAS f32x4*)(rp + 2 * NUP + DFF); gm1 = *(const GAS f32x4*)(rp + 3 * NUP); um1 = *(const GAS f32x4*)(rp + 3 * NUP + DFF); }
        float a0[4], a1[4];
#pragma unroll
        for (int k = 0; k < 4; ++k) {
            const float cg0 = bg[k] + wg0[k] * gm2[k] + wg1[k] * gm1[k] + wg2[k] * g0[k], cu0 = bu[k] + wu0[k] * um2[k] + wu1[k] * um1[k] + wu2[k] * u0[k];
            const float cg1 = bg[k] + wg0[k] * gm1[k] + wg1[k] * g0[k] + wg2[k] * g1[k], cu1 = bu[k] + wu0[k] * um1[k] + wu1[k] * u0[k] + wu2[k] * u1[k];
            a0[k] = cg0 * fast_sigmoid(cg0) * cu0; a1[k] = cg1 * fast_sigmoid(cg1) * cu1;
        }
        v2u w0, w1; w0.x = pk2(a0[0], a0[1]); w0.y = pk2(a0[2], a0[3]); w1.x = pk2(a1[0], a1[1]); w1.y = pk2(a1[2], a1[3]);
        GAS bf16* ar = act + (size_t)grp * 128 * DFF + c4;
        *(GAS v2u*)ar = w0; *(GAS v2u*)(ar + DFF) = w1;
    }
}

__device__ __forceinline__ void attn_phase(PTT PT, LAS unsigned char* lds) {
    const int tid = opaque_tid(), bid = opaque_bid(), lane = tid & 63, wave = __builtin_amdgcn_readfirstlane(tid >> 6), r = lane & 31, hh = lane >> 5;
    GAS unsigned char* ws = WSP;
    const GAS bf16* qb = (const GAS bf16*)(ws + WS_BIG); const GAS bf16* kb = (const GAS bf16*)(ws + WS_BIG + 128 * MiB); const GAS bf16* vb = (const GAS bf16*)(ws + WS_BIG + 160 * MiB);
    GAS bf16* ao = (GAS bf16*)(ws + WS_BIG + 192 * MiB);
    const GAS float* sinks = INP(14);
    LAS unsigned char* Ks = lds;
    LAS unsigned* Vt32 = (LAS unsigned*)(lds + 36864);
    LAS unsigned char* Vtb = lds + 36864;
    v4u kreg[4], vreg[2][2]; bf16x8 qn[2][4];
#define ATTN_FETCH(UU) do { const int kvh_ = (UU) & 3, nb_ = ((UU) >> 2) & 63, b_ = (UU) >> 8; const long t0_ = (long)b_ * SEQ + (long)nb_ * 128; \
        _Pragma("unroll") for (int it = 0; it < 4; ++it) { const int idx = tid + 512 * it, row = idx >> 3, c = idx & 7; const long tok = t0_ - 128 + row; \
            v4u val = {0u, 0u, 0u, 0u}; if (nb_ > 0 || row >= 128) val = *(const GAS v4u*)(kb + tok * 256 + kvh_ * 64 + c * 8); kreg[it] = val; } \
        _Pragma("unroll") for (int it = 0; it < 2; ++it) { const int p = tid & 127, c = (tid >> 7) + 4 * it; const long tok = t0_ - 128 + 2 * p; \
            v4u va = {0u, 0u, 0u, 0u}, vbv = va; if (nb_ > 0 || p >= 64) { va = *(const GAS v4u*)(vb + tok * 256 + kvh_ * 64 + c * 8); vbv = *(const GAS v4u*)(vb + (tok + 1) * 256 + kvh_ * 64 + c * 8); } \
            vreg[it][0] = va; vreg[it][1] = vbv; } \
        _Pragma("unroll") for (int i_ = 0; i_ < 2; ++i_) { const int wu_ = wave + 8 * i_; const GAS bf16* qrow_ = qb + (size_t)(t0_ + 32 * (wu_ >> 2) + r) * 1024 + (kvh_ * 4 + (wu_ & 3)) * 64 + 8 * hh; \
            _Pragma("unroll") for (int ks = 0; ks < 4; ++ks) qn[i_][ks] = *(const GAS bf16x8*)(qrow_ + 16 * ks); } } while (0)
    if (bid < 2048) ATTN_FETCH(bid);
    for (int u = bid; u < 2048; u += gridDim.x) {
        const int kvh = u & 3, nb = (u >> 2) & 63, b = u >> 8;
        const long t0 = (long)b * SEQ + (long)nb * 128;
        __syncthreads();
#pragma unroll
        for (int it = 0; it < 4; ++it) { const int idx = tid + 512 * it, row = idx >> 3, c = idx & 7; *(LAS v4u*)(Ks + row * 144 + c * 16) = kreg[it]; }
#pragma unroll
        for (int it = 0; it < 2; ++it) {
            const int p = tid & 127, c = (tid >> 7) + 4 * it; const v4u va = vreg[it][0], vbv = vreg[it][1];
            LAS unsigned* dst = Vt32 + (c * 8) * 130 + p;
            dst[0 * 130] = (va.x & 0xffffu) | (vbv.x << 16); dst[1 * 130] = (va.x >> 16) | (vbv.x & 0xffff0000u);
            dst[2 * 130] = (va.y & 0xffffu) | (vbv.y << 16); dst[3 * 130] = (va.y >> 16) | (vbv.y & 0xffff0000u);
            dst[4 * 130] = (va.z & 0xffffu) | (vbv.z << 16); dst[5 * 130] = (va.z >> 16) | (vbv.z & 0xffff0000u);
            dst[6 * 130] = (va.w & 0xffffu) | (vbv.w << 16); dst[7 * 130] = (va.w >> 16) | (vbv.w & 0xffff0000u);
        }
        __syncthreads();
        bf16x8 qc[2][4];
#pragma unroll
        for (int i = 0; i < 2; ++i)
#pragma unroll
            for (int ks = 0; ks < 4; ++ks) qc[i][ks] = qn[i][ks];
        if (u + (int)gridDim.x < 2048) ATTN_FETCH(u + (int)gridDim.x);
#pragma unroll
        for (int i = 0; i < 2; ++i) {
            const int wu = wave + 8 * i, g = wu & 3, qt = wu >> 2, head = kvh * 4 + g, i0 = 32 * qt;
            bf16x8 qf[4];
#pragma unroll
            for (int ks = 0; ks < 4; ++ks) qf[ks] = qc[i][ks];
            const float slope = exp2f(-0.5f * (float)(head + 1)), sink = sinks[head];
            const int kk_lo = (nb > 0) ? 0 : ((qt < 4) ? 4 - qt : 0);
            float mx = sink;
#pragma unroll 1
            for (int kk = kk_lo; kk < 5; ++kk) {
                f32x16 sc;
#pragma unroll
                for (int e = 0; e < 16; ++e) sc[e] = 0.f;
                const LAS unsigned char* kp = Ks + (32 * (qt + kk) + r) * 144 + 16 * hh;
#pragma unroll
                for (int ks = 0; ks < 4; ++ks) { const bf16x8 kf = *(const LAS bf16x8*)(kp + 32 * ks); sc = __builtin_amdgcn_mfma_f32_32x32x16_bf16(kf, qf[ks], sc, 0, 0, 0); }
                const int rdk = r + 128 - 32 * kk - 4 * hh;
#pragma unroll
                for (int e = 0; e < 16; ++e) {
                    const int dist = rdk - ((e & 3) + 8 * (e >> 2));
                    const float sv = fmaf(-slope, (float)dist, sc[e] * 0.125f);
                    mx = ((unsigned)dist < 128u) ? fmaxf(mx, sv) : mx;
                }
            }
            mx = fmaxf(mx, __shfl_xor(mx, 32));
            float sum = 0.f;
            f32x16 o0, o1;
#pragma unroll
            for (int e = 0; e < 16; ++e) { o0[e] = 0.f; o1[e] = 0.f; }
#pragma unroll 1
            for (int kk = kk_lo; kk < 5; ++kk) {
                f32x16 sc;
#pragma unroll
                for (int e = 0; e < 16; ++e) sc[e] = 0.f;
                const LAS unsigned char* kp = Ks + (32 * (qt + kk) + r) * 144 + 16 * hh;
#pragma unroll
                for (int ks = 0; ks < 4; ++ks) { const bf16x8 kf = *(const LAS bf16x8*)(kp + 32 * ks); sc = __builtin_amdgcn_mfma_f32_32x32x16_bf16(kf, qf[ks], sc, 0, 0, 0); }
                const int rdk = r + 128 - 32 * kk - 4 * hh;
#pragma unroll
                for (int e = 0; e < 16; ++e) {
                    const int dist = rdk - ((e & 3) + 8 * (e >> 2));
                    const float sv = fmaf(-slope, (float)dist, sc[e] * 0.125f);
                    const float ev = ((unsigned)dist < 128u) ? __expf(sv - mx) : 0.f;
                    sc[e] = ev; sum += ev;
                }
#pragma unroll
                for (int s2 = 0; s2 < 2; ++s2) {
                    v4u pw;
                    pw.x = pk2(sc[8 * s2 + 0], sc[8 * s2 + 1]); pw.y = pk2(sc[8 * s2 + 2], sc[8 * s2 + 3]);
                    pw.z = pk2(sc[8 * s2 + 4], sc[8 * s2 + 5]); pw.w = pk2(sc[8 * s2 + 6], sc[8 * s2 + 7]);
                    const bf16x8 pa = __builtin_bit_cast(bf16x8, pw);
                    const int key0 = 32 * (qt + kk) + 16 * s2 + 4 * hh;
                    const LAS unsigned char* v0p = Vtb + r * 520 + key0 * 2, * v1p = v0p + 32 * 520;
                    const v2u x0 = *(const LAS v2u*)(v0p), x1 = *(const LAS v2u*)(v0p + 16), y0 = *(const LAS v2u*)(v1p), y1 = *(const LAS v2u*)(v1p + 16);
                    v4u vw0, vw1; vw0.x = x0.x; vw0.y = x0.y; vw0.z = x1.x; vw0.w = x1.y; vw1.x = y0.x; vw1.y = y0.y; vw1.z = y1.x; vw1.w = y1.y;
                    o0 = __builtin_amdgcn_mfma_f32_32x32x16_bf16(pa, __builtin_bit_cast(bf16x8, vw0), o0, 0, 0, 0);
                    o1 = __builtin_amdgcn_mfma_f32_32x32x16_bf16(pa, __builtin_bit_cast(bf16x8, vw1), o1, 0, 0, 0);
                }
            }
            sum += __shfl_xor(sum, 32);
            const float inv = 1.0f / (sum + __expf(sink - mx));
#pragma unroll
            for (int e = 0; e < 16; ++e) {
                const int qr = (e & 3) + 8 * (e >> 2) + 4 * hh;
                const float ie = __shfl(inv, qr);
                GAS bf16* orow = ao + (size_t)(t0 + i0 + qr) * 1024 + head * 64 + r;
                orow[0] = (bf16)f2bf(o0[e] * ie); orow[32] = (bf16)f2bf(o1[e] * ie);
            }
        }
    }
#undef ATTN_FETCH
}

__device__ __forceinline__ void final_phase(PTT PT) {
    const int tid = opaque_tid(), lane = tid & 63, wave = tid >> 6;
    const int gw = opaque_bid() * 8 + wave, NGW = gridDim.x * 8;
    const GAS bf16* h = (const GAS bf16*)(WSP + WS_HA); const GAS float* ssq = (const GAS float*)(WSP + WS_SSQ + 7 * 4 * MiB); const GAS float* gf = INP(6);
    f32x4 g[4];
#pragma unroll
    for (int j = 0; j < 2; ++j) { g[2 * j] = *(const GAS f32x4*)(gf + 512 * j + lane * 8); g[2 * j + 1] = *(const GAS f32x4*)(gf + 512 * j + lane * 8 + 4); }
#if MK_DIAG
    float dA = 0.f; unsigned dM = 0;
    {
        const GAS unsigned long long* st = (const GAS unsigned long long*)(WSP + 4096);
        const float cyc = (float)st[2 * MK_DIAG_OP], us = (float)st[2 * MK_DIAG_OP + 1] * 0.01f, us2 = (float)st[2 * MK_DIAG_OP2 + 1] * 0.01f;
        if (MK_DIAG_MODE == 0) { dA = cyc / us * (1.0f / 100.0f); dM = (unsigned)(us * 1000.0f); }
        else { dA = us2 * (1.0f / 10.0f); dM = (unsigned)(us * 1000.0f); }
    }
#endif
#pragma unroll 8
    for (int r = gw; r < T; r += NGW) {
        const float rs = row_rstd(ssq, (size_t)r);
#pragma unroll
        for (int j = 0; j < 2; ++j) {
            const v4u w = *(const GAS v4u*)(h + (size_t)r * D + 512 * j + lane * 8);
            f32x4 o0, o1;
            o0[0] = bflo(w.x) * rs * g[2 * j][0]; o0[1] = bfhi(w.x) * rs * g[2 * j][1]; o0[2] = bflo(w.y) * rs * g[2 * j][2]; o0[3] = bfhi(w.y) * rs * g[2 * j][3];
            o1[0] = bflo(w.z) * rs * g[2 * j + 1][0]; o1[1] = bfhi(w.z) * rs * g[2 * j + 1][1]; o1[2] = bflo(w.w) * rs * g[2 * j + 1][2]; o1[3] = bfhi(w.w) * rs * g[2 * j + 1][3];
#if MK_DIAG
            { const unsigned e0 = (unsigned)r * 1024u + 512u * j + lane * 8u;
#pragma unroll
              for (int k = 0; k < 4; ++k) { if (e0 + k < dM) o0[k] += 1.0f; if (e0 + 4 + k < dM) o1[k] += 1.0f; }
              if (e0 == 0) o0[0] += dA; }
#endif
            GAS float* op = OUTP + (size_t)r * D + 512 * j + lane * 8;
            *(GAS f32x4*)op = o0; *(GAS f32x4*)(op + 4) = o1;
        }
    }
}

#define XB_TMO      128
#define XB_XCNT(j)  (256  + 64 * (j))
#define XB_XSUB(j)  (1280 + 64 * (j))
#define XB_XGEN(j)  (2304 + 64 * (j))
#define XB_TOP      3328
#define XB_TOPGEN   3392
#define XCD_BAR_WORDS 3456
#define XB_SPIN_CAP (1u << 18)

__device__ __forceinline__ unsigned xb_ld(unsigned* p)              { return __hip_atomic_load(p, __ATOMIC_RELAXED, __HIP_MEMORY_SCOPE_AGENT); }
__device__ __forceinline__ unsigned xb_add(unsigned* p, unsigned v) { return __hip_atomic_fetch_add(p, v, __ATOMIC_RELAXED, __HIP_MEMORY_SCOPE_AGENT); }
__device__ __forceinline__ unsigned xb_xcc_id() { return (unsigned)__builtin_amdgcn_s_getreg((3 << 11) | 20) & 0xFu; }
#define XB_SPIN(cond, bar) do { unsigned _sp = 0; while (cond) { __builtin_amdgcn_s_sleep(1); \
    if ((++_sp & 255u) == 0u) { if (xb_ld(&(bar)[XB_TMO])) break; if (_sp > XB_SPIN_CAP) { atomicAdd(&(bar)[XB_TMO], 1u); break; } } } } while (0)

struct XcdBarrier {
    unsigned* bar; unsigned x;
    volatile LAS unsigned* st;
};

__device__ __forceinline__ XcdBarrier xcd_barrier_post(unsigned* bar, volatile LAS unsigned* st) {
    XcdBarrier b; b.bar = bar; b.x = xb_xcc_id(); b.st = st;
    if (threadIdx.x == 0) (void)xb_add(&bar[XB_XCNT(b.x)], 1u);
    return b;
}
__device__ __forceinline__ void xcd_barrier_complete(unsigned* bar, unsigned x, unsigned& nloc, unsigned& nx) {
    const unsigned G = gridDim.x * gridDim.y * gridDim.z;
    unsigned sum, cnt, mine, sp = 0u;
    for (;;) {
        sum = 0u; cnt = 0u; mine = 0u;
#pragma unroll
        for (unsigned j = 0; j < 16; ++j) { const unsigned c = xb_ld(&bar[XB_XCNT(j)]); sum += c; cnt += (c > 0u) ? 1u : 0u; mine = (j == x) ? c : mine; }
        if (sum == G) break;
        __builtin_amdgcn_s_sleep(1);
        if ((++sp & 255u) == 0u) { if (xb_ld(&bar[XB_TMO])) break; if (sp > XB_SPIN_CAP) { atomicAdd(&bar[XB_TMO], 1u); break; } }
    }
    nloc = mine > 0u ? mine : 1u; nx = cnt > 0u ? cnt : 1u;
}

__device__ __forceinline__ void xcd_barrier(const XcdBarrier& b) {
    asm volatile("s_waitcnt vmcnt(0)" ::: "memory");
    __syncthreads();
    if (threadIdx.x == 0) {
        unsigned* bar = b.bar;
        __builtin_amdgcn_s_waitcnt(0);
        unsigned nloc = b.st[0], nx = b.st[1];
        if (nloc == 0u) { xcd_barrier_complete(bar, b.x, nloc, nx); b.st[0] = nloc; b.st[1] = nx; }
        const unsigned old = xb_add(&bar[XB_XSUB(b.x)], 1u);
        const unsigned gen = old / nloc;
        if (old + 1u == (gen + 1u) * nloc) {
            __builtin_amdgcn_fence(__ATOMIC_RELEASE, "agent");
            asm volatile("s_waitcnt vmcnt(0)" ::: "memory");
            const unsigned og = xb_add(&bar[XB_TOP], 1u);
            const unsigned tg = og / nx;
            if (og + 1u == (tg + 1u) * nx) xb_add(&bar[XB_TOPGEN], 1u);
            else XB_SPIN(xb_ld(&bar[XB_TOPGEN]) == tg, bar);
            __builtin_amdgcn_fence(__ATOMIC_ACQUIRE, "agent");
            xb_add(&bar[XB_XGEN(b.x)], 1u);
            asm volatile("s_waitcnt vmcnt(0)" ::: "memory");
        } else {
            XB_SPIN(xb_ld(&bar[XB_XGEN(b.x)]) == gen, bar);
            __builtin_amdgcn_fence(__ATOMIC_ACQUIRE, "agent");
            asm volatile("s_waitcnt vmcnt(0)" ::: "memory");
        }
    }
    __syncthreads();
}

enum { OP_PRO = 0, OP_GEMM = 1, OP_SPATIAL = 2, OP_FIX = 3, OP_ATTN = 4, OP_FINAL = 5 };
constexpr int N_OPS = 18;
__host__ __device__ inline int op_kind(int op) {
    switch (op) { case 0: return OP_PRO; case 2: return OP_SPATIAL; case 5: case 13: return OP_FIX; case 10: return OP_ATTN; case 17: return OP_FINAL; default: return OP_GEMM; }
}
__host__ __device__ inline bool op_sync_after(int op) { return !(op == 6 || op == 14 || op == 17); }

__device__ __forceinline__ void make_gemm(int op, PTT PT, pg8::Gemm& g, Epi& E) {
    GAS unsigned char* ws = WSP;
    GAS bf16* HA = (GAS bf16*)(ws + WS_HA); GAS bf16* HB = (GAS bf16*)(ws + WS_HB); GAS bf16* PE = (GAS bf16*)(ws + WS_PE); GAS bf16* BIG = (GAS bf16*)(ws + WS_BIG);
    GAS float* SSQ = (GAS float*)(ws + WS_SSQ); const size_t SS = (size_t)T * 16;
    GAS bf16* ACT = (GAS bf16*)(ws + WS_ACT);
    E.mode = EM_PLAIN; E.out = nullptr; E.ldo = 1024; E.res = nullptr; E.pe = nullptr; E.ssq_in = nullptr; E.ssq_out = nullptr; E.bias = nullptr; E.out_k = nullptr; E.out_v = nullptr; E.cw = nullptr; E.skip = 0; E.par = nullptr;
    g.A = (const pg8::bf16_t*)(nullptr); g.Bt = (const pg8::bf16_t*)(nullptr); g.M = T; g.N = 1024; g.K = 1024; g.aperm = 0;
    const int layer = (op >= 12) ? 1 : 0;
    switch (op) {
        case 1:  g.A = (const pg8::bf16_t*)(HA); g.Bt = (const pg8::bf16_t*)((const GAS bf16*)(ws + WS_WIN)); g.N = 2048; E.mode = EM_GELU; E.out = BIG; E.ldo = 2048; E.ssq_in = SSQ; E.ssq_out = SSQ + SS; break;
        case 3:  g.A = (const pg8::bf16_t*)(BIG + (size_t)T * 2048); g.Bt = (const pg8::bf16_t*)((const GAS bf16*)(ws + WS_WOUT)); E.mode = EM_RES; E.out = HB; E.res = HA; E.ssq_out = SSQ + 2 * SS; break;
        case 4: case 12:
            g.A = (const pg8::bf16_t*)(layer ? HA : HB); g.Bt = (const pg8::bf16_t*)((const GAS bf16*)(ws + WS_WUP) + (size_t)layer * NUP * 1024); g.N = NUP; g.aperm = 1;
            E.mode = EM_UPCONV; E.out = ACT; E.ldo = DFF; E.ssq_in = SSQ + (layer ? 5 : 2) * SS; E.ssq_out = (GAS float*)(ws + WS_RAW);
            E.cw = INP(17) + (size_t)layer * 3 * NUP; E.bias = INP(18) + (size_t)layer * NUP; E.out_k = (GAS bf16*)(ws + 512 * 1024); break;
        case 6: case 14:
            g.A = (const pg8::bf16_t*)(ACT); g.Bt = (const pg8::bf16_t*)((const GAS bf16*)(ws + WS_WDN) + (size_t)layer * 1024 * DFF); g.K = DFF;
            E.mode = EM_RES; E.out = layer ? HB : HA; E.res = layer ? HA : HB; E.ssq_out = SSQ + (layer ? 6 : 3) * SS; break;
        case 7: case 15:
            g.A = (const pg8::bf16_t*)((const GAS bf16*)(ws + WS_PB) + (size_t)layer * T * 256); g.Bt = (const pg8::bf16_t*)((const GAS bf16*)(ws + WS_WPE) + (size_t)layer * 1024 * 256); g.K = 256; E.mode = EM_PLAIN; E.out = PE; break;
        case 8: case 16: {
            const GAS bf16* hin = layer ? HB : HA; GAS bf16* hout = layer ? HA : HB;
            g.A = (const pg8::bf16_t*)(hin); g.Bt = (const pg8::bf16_t*)((const GAS bf16*)(ws + WS_WG) + (size_t)layer * 1024 * 1024); E.mode = EM_GATE; E.out = hout; E.res = hin; E.pe = PE;
            E.ssq_in = SSQ + (layer ? 6 : 3) * SS; E.ssq_out = SSQ + (layer ? 7 : 4) * SS; E.bias = INP(22) + layer * 1024; break; }
        case 9:  g.A = (const pg8::bf16_t*)(HB); g.Bt = (const pg8::bf16_t*)((const GAS bf16*)(ws + WS_WQKV)); g.N = 1536; E.mode = EM_QKV; E.out = BIG; E.out_k = BIG + (size_t)T * 1024; E.out_v = BIG + (size_t)T * 1280; E.ssq_in = SSQ + 4 * SS; break;
        case 11: g.A = (const pg8::bf16_t*)(BIG + (size_t)T * 1536); g.Bt = (const pg8::bf16_t*)((const GAS bf16*)(ws + WS_WO)); E.mode = EM_RES; E.out = HA; E.res = HB; E.ssq_out = SSQ + 5 * SS; break;
        default: break;
    }
}

__global__ void __launch_bounds__(512, 2) fwd_kernel(Args args) {
    extern __shared__ __attribute__((aligned(16))) unsigned char lds_raw[];
    LAS unsigned char* lds = (LAS unsigned char*)lds_raw;
    cg::grid_group grid = cg::this_grid();
    {
        LAS unsigned long long* PW = (LAS unsigned long long*)(lds + 131072);
        if (threadIdx.x == 0) {
#pragma unroll
            for (int i = 0; i < 23; ++i) PW[i] = (unsigned long long)args.in[i];
            PW[23] = (unsigned long long)args.out; PW[24] = (unsigned long long)args.ws;
            ((LAS unsigned*)(lds + 131072 + 512))[0] = 0u; ((LAS unsigned*)(lds + 131072 + 512))[1] = 0u;
        }
        __syncthreads();
    }
    PTT PT = (PTT)(lds + 131072);
    if (threadIdx.x == 0) {
        unsigned* bar0 = (unsigned*)(args.ws + WS_BAR); const unsigned x0 = xb_xcc_id();
        const unsigned rank0 = xb_add(&bar0[XB_XCNT(x0)], 1u);
        ((LAS unsigned*)(lds + 131072 + 512))[2] = x0; ((LAS unsigned*)(lds + 131072 + 512))[3] = rank0;
    }
    __syncthreads();
    for (int op = args.op_lo; op < args.op_hi; ++op) {
        const int kind = op_kind(op);
#if MK_DIAG
        if (blockIdx.x == 0 && threadIdx.x == 0) { GAS unsigned long long* st = (GAS unsigned long long*)(WSP + 4096); st[64 + 2 * op] = (unsigned long long)clock64(); st[65 + 2 * op] = (unsigned long long)wall_clock64(); }
#endif
        for (int rep = 0; rep < ((MK_REP_MASK >> op) & 1u ? 2 : 1); ++rep) {
        if (rep) __syncthreads();
        if (kind == OP_GEMM) {
            pg8::Gemm g; Epi E; make_gemm(op, PT, g, E); E.skip = (rep > 0 && MK_REP_NOEPI) ? 1 : 0; E.par = (LAS float*)(lds + 131072 + 1024);
            pg8::StaticOrder S; S.init(g.M, g.N, (int)gridDim.x, (int)blockIdx.x);
            pg8::gemm_phase<Epi, pg8::StaticOrder, false>(lds, g, S, E, nullptr);
        } else if (kind == OP_PRO) {
            prologue(PT, lds);
        } else if (kind == OP_SPATIAL) {
            spatial_phase(PT, lds);
        } else if (kind == OP_FIX) {
            const int layer = (op >= 12) ? 1 : 0;
            fix_phase((const GAS float*)(WSP + WS_RAW), (GAS bf16*)(WSP + WS_ACT), INP(17) + (size_t)layer * 3 * NUP, INP(18) + (size_t)layer * NUP);
        } else if (kind == OP_ATTN) {
            attn_phase(PT, lds);
        } else {
            final_phase(PT);
        }
        }
#if MK_DIAG
        if (blockIdx.x == 0 && threadIdx.x == 0) { GAS unsigned long long* st = (GAS unsigned long long*)(WSP + 4096); st[2 * op] = (unsigned long long)clock64() - st[64 + 2 * op]; st[1 + 2 * op] = (unsigned long long)wall_clock64() - st[65 + 2 * op]; }
#endif
        if (op_sync_after(op) && op + 1 < args.op_hi) { if (args.op_lo < 0) grid.sync();   XcdBarrier xbar; xbar.bar = (unsigned*)(WSP + WS_BAR); xbar.st = (volatile LAS unsigned*)(lds + 131072 + 512); xbar.x = (unsigned)__builtin_amdgcn_readfirstlane((int)xbar.st[2]); xcd_barrier(xbar); }
        else __syncthreads();
    }
}
}

#ifndef MK_SINGLE
#define MK_SINGLE 1
#endif
#ifndef MK_MAXOP
#define MK_MAXOP N_OPS
#endif
extern "C" void kernel_launch(void* const* d_in, const int* in_sizes, int n_in, void* d_out, int out_size, void* d_ws, size_t ws_size, hipStream_t stream) {
    using namespace mk;
    static int grid = 0;
    if (grid == 0) {
        if (n_in != 23 || ws_size < WS_END) { fprintf(stderr, "kernel_launch: unexpected n_in %d / ws_size %zu\n", n_in, ws_size); grid = -1; return; }
        int dev = 0, cus = 0, per_cu = 0;
        hipGetDevice(&dev); hipDeviceGetAttribute(&cus, hipDeviceAttributeMultiprocessorCount, dev);
        if (hipFuncSetAttribute((const void*)fwd_kernel, hipFuncAttributeMaxDynamicSharedMemorySize, LDS_BYTES) != hipSuccess) { fprintf(stderr, "kernel_launch: hipFuncSetAttribute failed\n"); grid = -1; return; }
        hipOccupancyMaxActiveBlocksPerMultiprocessor(&per_cu, (const void*)fwd_kernel, 512, LDS_BYTES);
        if (per_cu < 1) { fprintf(stderr, "kernel_launch: occupancy query says %d blocks per CU\n", per_cu); per_cu = 1; }
        (void)hipGetLastError();
        grid = cus;
    }
    if (grid < 0) return;
    Args a{};
    for (int i = 0; i < 23; ++i) a.in[i] = (const float*)d_in[i];
    a.out = (float*)d_out; a.ws = (unsigned char*)d_ws;
#if MK_SINGLE
    if (hipMemsetAsync((char*)d_ws + WS_BAR, 0, WS_BAR_BYTES, stream) != hipSuccess) { fprintf(stderr, "kernel_launch: hipMemsetAsync failed\n"); return; }
    a.op_lo = 0; a.op_hi = MK_MAXOP;
    void* kargs[] = {&a};
    hipError_t e = hipLaunchCooperativeKernel((const void*)fwd_kernel, dim3(grid), dim3(512), kargs, LDS_BYTES, stream);
    if (e != hipSuccess) fprintf(stderr, "cooperative launch failed: %s (grid %d)\n", hipGetErrorString(e), grid);
#else
    int lo = 0;
    for (int op = 0; op < MK_MAXOP; ++op) {
        if (op_sync_after(op) || op == MK_MAXOP - 1) {
            a.op_lo = lo; a.op_hi = op + 1; lo = op + 1;
            hipLaunchKernelGGL(fwd_kernel, dim3(grid), dim3(512), LDS_BYTES, stream, a);
        }
    }
#endif
}
```

```cpp
#include <hip/hip_runtime.h>
#include <hip/hip_cooperative_groups.h>
#include <cstdio>
namespace cg = cooperative_groups;
namespace pg8 {
#define PG8_LAS __attribute__((address_space(3)))
typedef unsigned short bf16_t;
typedef short bf16x8 __attribute__((ext_vector_type(8)));
typedef float f32x4 __attribute__((ext_vector_type(4)));
typedef unsigned u32x4 __attribute__((ext_vector_type(4)));
constexpr int BM = 256, BK = 64, HALF = 128, HTB = HALF * BK * 2  , STAGE_BYTES = 8 * HTB, NXCD = 8, WGM = 8;

__host__ __device__ __forceinline__ int lds_byte(int r, int c) { const int st = (r >> 4) * 2 + (c >> 5), rr = r & 15, cc = c & 31, ob = rr * 64 + cc * 2; return st * 1024 + (ob ^ (((ob >> 9) & 1) << 5)); }
__host__ __device__ __forceinline__ void stage_rc(int b, int& R, int& C) { const int st = b / 1024, sb = b % 1024, swz = sb ^ (((sb >> 9) & 1) << 5); R = (st >> 1) * 16 + swz / 64; C = (st & 1) * 32 + (swz % 64) / 2; }
__host__ __device__ __forceinline__ int perm32(int rho) { const int n = rho >> 4, i = rho & 15; return 8 * (i >> 2) + 4 * n + (i & 3); }

struct Unit { int pm, pn; };
struct Gemm { const bf16_t* A; const bf16_t* Bt; int M, N, K, aperm; };

struct StaticOrder {
    int nM, nN, nwg, G, c;
    __host__ __device__ void init(int M, int N, int G_, int c_) { nM = M / BM; nN = N / BM; nwg = nM * nN; G = G_; c = c_; }
    __host__ __device__ bool next(int i, Unit& u) const {
        const long L = (long)i * G + c; if (L >= nwg) return false;
        int wgid = (int)L; { const int q = nwg / NXCD, r = nwg % NXCD, xcd = wgid % NXCD, off = wgid / NXCD; wgid = (xcd < r ? xcd * (q + 1) : r * (q + 1) + (xcd - r) * q) + off; }
        const int nig = WGM * nN, gid = wgid / nig, fm = gid * WGM, gsz = (nM - fm) < WGM ? (nM - fm) : WGM;
        u.pm = fm + ((wgid % nig) % gsz); u.pn = (wgid % nig) / gsz; return true;
    }
    __device__ __forceinline__ void a_ready(const Unit&) const {}
    __device__ __forceinline__ void done(const Unit&) const {}
};
__device__ __forceinline__ unsigned cvt_pk_bf16(float lo, float hi) { unsigned r; asm volatile("v_cvt_pk_bf16_f32 %0, %1, %2" : "=v"(r) : "v"(lo), "v"(hi)); return r; }
typedef float f32x2 __attribute__((ext_vector_type(2)));
template <class Epi, class Sched, bool STAMP = false>
__device__ __forceinline__ void gemm_phase(PG8_LAS unsigned char* lds, const Gemm g, const Sched& S, const Epi& E, unsigned long long* stamps) {
    int tid_ = threadIdx.x; asm volatile("" : "+v"(tid_));
    const int tid = tid_, wid = __builtin_amdgcn_readfirstlane(tid >> 6), lane = tid & 63, wr = wid >> 2, wc = wid & 3, fr = lane & 15, fq = lane >> 4;
    const int K = g.K, nt = K / BK;
    int nts = 0;
    if (STAMP && stamps && tid < 64) { stamps[tid] = 0ull; if (tid == 62) stamps[62] = (unsigned long long)wall_clock64(); }
#define PG8_STAMP() do { if (STAMP && stamps && wid == 0 && nts < 62) { const unsigned long long _c = (unsigned long long)clock64(); if (lane == 0) stamps[nts] = _c; ++nts; } } while (0)
    PG8_STAMP();
    unsigned voffA[2], voffB[2];
#pragma unroll
    for (int i = 0; i < 2; ++i) { int R, C; stage_rc(tid * 16 + i * 8192, R, C); const int Rb = Epi::PERM ? ((R & ~31) + perm32(R & 31)) : R;
        const int Ra = g.aperm ? (((R >> 6) << 7) + (R & 63)) : R;
        voffA[i] = (unsigned)(Ra * K + C) * 2u; voffB[i] = (unsigned)(Rb * K + C) * 2u; }
    const size_t kstep = (size_t)(BK * 2);
    const size_t hstep = (size_t)HALF * K * 2;
    const size_t hstepA = g.aperm ? hstep / 2 : hstep;
    const size_t tstep = 2 * hstep;
    const unsigned ldsw = (unsigned)wid * 1024u;
    const int aoff = lds_byte(wr * 64 + fr, fq * 8), boff = lds_byte(wc * 32 + fr, fq * 8);
#define PG8_SA(b, h) (((b) * 2 + (h)) * HTB)
#define PG8_SB(b, h) ((4 + (b) * 2 + (h)) * HTB)
#define PG8_STAGE(bufoff, gbase, voff) do { _Pragma("unroll") for (int _i = 0; _i < 2; ++_i) \
        __builtin_amdgcn_global_load_lds((const unsigned*)((const char*)(gbase) + (voff)[_i]), (PG8_LAS unsigned*)(lds + (bufoff) + ldsw + _i * 8192), 16, 0, 0); } while (0)
#define PG8_LDA(dst, b, h) do { _Pragma("unroll") for (int m = 0; m < 4; ++m) _Pragma("unroll") for (int k = 0; k < 2; ++k) dst[m][k] = *(const PG8_LAS bf16x8*)(lds + PG8_SA(b, h) + aoff + m * 2048 + k * 1024); } while (0)
#define PG8_LDB(dst, b, h) do { _Pragma("unroll") for (int n = 0; n < 2; ++n) _Pragma("unroll") for (int k = 0; k < 2; ++k) dst[n][k] = *(const PG8_LAS bf16x8*)(lds + PG8_SB(b, h) + boff + n * 2048 + k * 1024); } while (0)
#define PG8_MMA(ai, bj, At, Bt) do { __builtin_amdgcn_s_setprio(1); _Pragma("unroll") for (int m = 0; m < 4; ++m) _Pragma("unroll") for (int n = 0; n < 2; ++n) _Pragma("unroll") for (int k = 0; k < 2; ++k) \
        acc[ai][bj][m][n] = __builtin_amdgcn_mfma_f32_16x16x32_bf16(Bt[n][k], At[m][k], acc[ai][bj][m][n], 0, 0, 0); __builtin_amdgcn_s_setprio(0); } while (0)
#define PG8_WAIT_V(n) asm volatile("s_waitcnt vmcnt(" #n ")" ::: "memory")
#define PG8_WAIT_L(n) asm volatile("s_waitcnt lgkmcnt(" #n ")" ::: "memory")
#define PG8_BAR __builtin_amdgcn_s_barrier()
#define PG8_SCHED __builtin_amdgcn_sched_barrier(0)
    Unit cur, nxt; int ui = 0;
    if (!S.next(0, cur)) return;
    f32x4 acc[2][2][4][2];
#pragma unroll
    for (int a = 0; a < 2; ++a)
#pragma unroll
        for (int b = 0; b < 2; ++b)
#pragma unroll
            for (int m = 0; m < 4; ++m)
#pragma unroll
                for (int n = 0; n < 2; ++n) acc[a][b][m][n] = (f32x4){0.f, 0.f, 0.f, 0.f};
    bf16x8 At[4][2], B0[2][2], B1[2][2];
    const char* cA = (const char*)g.A + (size_t)cur.pm * tstep; const char* cB = (const char*)g.Bt + (size_t)cur.pn * tstep;
    S.a_ready(cur);
    PG8_STAGE(PG8_SB(0, 0), cB, voffB); PG8_STAGE(PG8_SA(0, 0), cA, voffA); PG8_STAGE(PG8_SB(0, 1), cB + hstep, voffB); PG8_STAGE(PG8_SA(0, 1), cA + hstepA, voffA);
    if (wr == 1) PG8_BAR;
    PG8_WAIT_V(4); PG8_BAR;
    PG8_STAGE(PG8_SB(1, 0), cB + kstep, voffB); PG8_STAGE(PG8_SA(1, 0), cA + kstep, voffA); PG8_STAGE(PG8_SB(1, 1), cB + hstep + kstep, voffB);
    PG8_WAIT_V(6); PG8_BAR;
    PG8_STAMP();
    for (;;) {
        const bool has_next = S.next(ui + 1, nxt);
        const char* nA = has_next ? (const char*)g.A + (size_t)nxt.pm * tstep : cA; const char* nB = has_next ? (const char*)g.Bt + (size_t)nxt.pn * tstep : cB;
        for (int t = 0; t < nt; t += 2) {
            const bool last = (t == nt - 2);
            const char* a1 = cA + (size_t)(t + 1) * kstep;
            const char* a2 = last ? nA : cA + (size_t)(t + 2) * kstep; const char* b2 = last ? nB : cB + (size_t)(t + 2) * kstep;
            const char* a3 = a2 + kstep; const char* b3 = b2 + kstep;
            if (last && has_next) S.a_ready(nxt);
            PG8_LDB(B0, 0, 0); PG8_SCHED; PG8_LDA(At, 0, 0); PG8_STAGE(PG8_SA(1, 1), a1 + hstepA, voffA);
            PG8_WAIT_L(8); PG8_BAR; PG8_WAIT_L(0); PG8_MMA(0, 0, At, B0); PG8_BAR; PG8_SCHED;
            PG8_LDB(B1, 0, 1); PG8_STAGE(PG8_SB(0, 0), b2, voffB);
            PG8_BAR; PG8_WAIT_L(0); PG8_MMA(0, 1, At, B1); PG8_BAR;
            PG8_LDA(At, 0, 1); PG8_STAGE(PG8_SA(0, 0), a2, voffA);
            PG8_BAR; PG8_WAIT_L(0); PG8_MMA(1, 0, At, B0); PG8_BAR; PG8_SCHED;
            PG8_STAGE(PG8_SB(0, 1), b2 + hstep, voffB);
            PG8_WAIT_V(6); PG8_BAR; PG8_MMA(1, 1, At, B1); PG8_BAR;
            PG8_LDB(B0, 1, 0); PG8_SCHED; PG8_LDA(At, 1, 0); PG8_STAGE(PG8_SA(0, 1), a2 + hstepA, voffA);
            PG8_WAIT_L(8); PG8_BAR; PG8_WAIT_L(0); PG8_MMA(0, 0, At, B0); PG8_BAR; PG8_SCHED;
            PG8_LDB(B1, 1, 1); PG8_STAGE(PG8_SB(1, 0), b3, voffB);
            PG8_BAR; PG8_WAIT_L(0); PG8_MMA(0, 1, At, B1); PG8_BAR;
            PG8_LDA(At, 1, 1); PG8_STAGE(PG8_SA(1, 0), a3, voffA);
            PG8_BAR; PG8_WAIT_L(0); PG8_MMA(1, 0, At, B0); PG8_BAR; PG8_SCHED;
            PG8_STAGE(PG8_SB(1, 1), b3 + hstep, voffB);
            PG8_WAIT_V(6); PG8_BAR; PG8_MMA(1, 1, At, B1); PG8_BAR;
        }
        PG8_STAMP();
        if constexpr (!Epi::AFTER_DRAIN) { E(acc, cur, wr, wc, fr, fq); S.done(cur); }
        PG8_STAMP();
        if (!has_next) break;
#pragma unroll
        for (int a = 0; a < 2; ++a)
#pragma unroll
            for (int b = 0; b < 2; ++b)
#pragma unroll
                for (int m = 0; m < 4; ++m)
#pragma unroll
                    for (int n = 0; n < 2; ++n) acc[a][b][m][n] = (f32x4){0.f, 0.f, 0.f, 0.f};
        cur = nxt; cA = nA; cB = nB; ++ui;
    }
    PG8_WAIT_V(0);
    if (wr == 0) PG8_BAR;
    PG8_BAR;
    if constexpr (Epi::AFTER_DRAIN) { E.fused(acc, cur, wr, wc, fr, fq, lds, wid, lane); S.done(cur); }
    PG8_STAMP();
    if (STAMP && stamps && tid == 0) stamps[63] = (unsigned long long)wall_clock64();
#undef PG8_STAMP
#undef PG8_SA
#undef PG8_SB
#undef PG8_STAGE
#undef PG8_LDA
#undef PG8_LDB
#undef PG8_MMA
#undef PG8_WAIT_V
#undef PG8_WAIT_L
#undef PG8_BAR
#undef PG8_SCHED
}
}

namespace mk {
using pg8::bf16x8; using pg8::f32x4; using pg8::Unit;
#define LAS __attribute__((address_space(3)))
#define GAS __attribute__((address_space(1)))
typedef unsigned short bf16;
typedef unsigned v4u __attribute__((ext_vector_type(4)));
typedef unsigned v2u __attribute__((ext_vector_type(2)));
typedef float f32x16 __attribute__((ext_vector_type(16)));
typedef float f32x2_t __attribute__((ext_vector_type(2)));
typedef __bf16 bf16x2_t __attribute__((ext_vector_type(2)));

constexpr int T = 65536, D = 1024, SEQ = 8192, DFF = 2816, NUP = 5632, TH = 32768  ;
constexpr float EPS = 1e-6f;
constexpr size_t MiB = (size_t)1 << 20;
constexpr size_t WS_WIN = 1 * MiB, WS_WOUT = 5 * MiB, WS_WQKV = 7 * MiB, WS_WO = 10 * MiB, WS_WUP = 12 * MiB, WS_WDN = 34 * MiB, WS_WPE = 45 * MiB, WS_WG = 46 * MiB, WS_WS = 50 * MiB;
constexpr size_t WS_SSQ = 56 * MiB;
constexpr size_t WS_PB = 88 * MiB;
constexpr size_t WS_HA = 152 * MiB, WS_HB = 280 * MiB;
constexpr size_t WS_PE = 808 * MiB;
constexpr size_t WS_BIG = 536 * MiB;
constexpr size_t WS_ACT = 408 * MiB;
constexpr size_t WS_RAW = 760 * MiB;
constexpr size_t WS_END = 1024 * MiB;
constexpr int LDS_BYTES = 147456;
constexpr size_t WS_BAR = 64 * 1024, WS_BAR_BYTES = 16 * 1024;

#ifndef MK_DIAG
#define MK_DIAG 0
#endif
#ifndef MK_DIAG_OP
#define MK_DIAG_OP 4
#endif
#ifndef MK_DIAG_MODE
#define MK_DIAG_MODE 0
#endif
#ifndef MK_DIAG_OP2
#define MK_DIAG_OP2 6
#endif
#ifndef MK_REP_MASK
#define MK_REP_MASK 0u
#endif
#ifndef MK_REP_NOEPI
#define MK_REP_NOEPI 0
#endif
struct Args {
    const float* in[23]; float* out; unsigned char* ws; int op_lo, op_hi;
};
typedef LAS const unsigned long long* PTT;
__device__ __forceinline__ unsigned long long ldp(PTT PT, int i) {
    asm volatile("" ::: "memory");
    const unsigned long long v = PT[i];
    const unsigned lo = __builtin_amdgcn_readfirstlane((unsigned)v), hi = __builtin_amdgcn_readfirstlane((unsigned)(v >> 32));
    return ((unsigned long long)hi << 32) | lo;
}
#define INP(i) ((const GAS float*)ldp(PT, (i)))
#define OUTP ((GAS float*)ldp(PT, 23))
#define WSP ((GAS unsigned char*)ldp(PT, 24))

__device__ __forceinline__ int opaque_tid() { int t = threadIdx.x; asm volatile("" : "+v"(t)); return t; }
__device__ __forceinline__ int opaque_bid() { int b = blockIdx.x; asm volatile("" : "+s"(b)); return b; }
__device__ __forceinline__ unsigned f2bf(float f) { unsigned u = __builtin_bit_cast(unsigned, f); return (u + 0x7fffu + ((u >> 16) & 1u)) >> 16; }
__device__ __forceinline__ unsigned pk2(float lo, float hi) { f32x2_t v = {lo, hi}; bf16x2_t b = __builtin_convertvector(v, bf16x2_t); return __builtin_bit_cast(unsigned, b); }
__device__ __forceinline__ float bflo(unsigned w) { return __builtin_bit_cast(float, w << 16); }
__device__ __forceinline__ float bfhi(unsigned w) { return __builtin_bit_cast(float, w & 0xffff0000u); }
__device__ __forceinline__ float bf2f(bf16 b) { return __builtin_bit_cast(float, ((unsigned)b) << 16); }
__device__ __forceinline__ float fast_sigmoid(float x) { return __builtin_amdgcn_rcpf(1.0f + __expf(-x)); }
__device__ __forceinline__ float gelu_tanh(float x) { const float y = x * (1.5957691216f + 0.0713548163f * x * x); return x * __builtin_amdgcn_rcpf(1.0f + __expf(-y)); }
__device__ __forceinline__ float row_rstd(const GAS float* ssq, size_t row) {
    const f32x4 a = *(const GAS f32x4*)(ssq + (row) * 4), b = *(const GAS f32x4*)(ssq + ((size_t)T + row) * 4), c = *(const GAS f32x4*)(ssq + ((size_t)2 * T + row) * 4), d = *(const GAS f32x4*)(ssq + ((size_t)3 * T + row) * 4);
    const float s = ((a[0] + a[1]) + (a[2] + a[3])) + ((b[0] + b[1]) + (b[2] + b[3])) + ((c[0] + c[1]) + (c[2] + c[3])) + ((d[0] + d[1]) + (d[2] + d[3]));
    return rsqrtf(s * (1.0f / 1024.0f) + EPS);
}
__device__ __forceinline__ float wave_sum(float v) {
#pragma unroll
    for (int o = 1; o < 64; o <<= 1) v += __shfl_xor(v, o);
    return v;
}

template <bool APERM> __device__ __forceinline__ void wave_rstd8(const GAS float* ssq, int rowbase, int fq, float (&rs)[8]) {
    f32x4 v[8];
#pragma unroll
    for (int q = 0; q < 8; ++q) { const int row = rowbase + (APERM ? 16 * q : (q >> 2) * 128 + (q & 3) * 16); v[q] = *(const GAS f32x4*)(ssq + ((size_t)fq * T + (size_t)row) * 4); }
#pragma unroll
    for (int q = 0; q < 8; ++q) { float t = (v[q][0] + v[q][1]) + (v[q][2] + v[q][3]); t += __shfl_xor(t, 16); t += __shfl_xor(t, 32); rs[q] = rsqrtf(t * (1.0f / 1024.0f) + EPS); }
}

enum { EM_PLAIN = 0, EM_GELU = 1, EM_RES = 2, EM_SCALE = 3, EM_GATE = 4, EM_QKV = 5, EM_UPCONV = 6 };
__device__ __forceinline__ float dpp_ror1(float x) { return __builtin_bit_cast(float, __builtin_amdgcn_mov_dpp(__builtin_bit_cast(int, x), 0x121, 0xf, 0xf, false)); }
__device__ __forceinline__ float dpp_ror2(float x) { return __builtin_bit_cast(float, __builtin_amdgcn_mov_dpp(__builtin_bit_cast(int, x), 0x122, 0xf, 0xf, false)); }
struct Epi {
    static constexpr bool PERM = true, AFTER_DRAIN = false;
    int mode; GAS bf16* out; int ldo; const GAS bf16* res; const GAS bf16* pe; const GAS float* ssq_in; GAS float* ssq_out; const GAS float* bias; GAS bf16* out_k; GAS bf16* out_v; const GAS float* cw; int skip; LAS float* par;
    __device__ __forceinline__ void upconv(f32x4 (&acc)[2][2][4][2], const Unit& u, int wr, int wc, int fr, int fq) const {
        const int tok0 = u.pm * 256 + wr * 128, jc = u.pn * 128 + wc * 32 + 8 * fq, lane = fq * 16 + fr, wid = wr * 4 + wc;
        const int pa = lane >> 3, pc = 4 * (lane & 7);
        const GAS float* psrc = ((pa < 6) ? cw + (pa % 3) * NUP + ((pa >= 3) ? DFF : 0) : bias + ((pa == 7) ? DFF : 0)) + u.pn * 128 + wc * 32 + pc;
        const f32x4 pv = *(const GAS f32x4*)psrc;
        float rs[8]; wave_rstd8<true>(ssq_in, tok0 + fr, fq, rs);
        LAS float* P = par + wid * 256;
        *(LAS f32x4*)(P + pa * 32 + pc) = pv;
#pragma unroll
        for (int q = 0; q < 8; ++q) { acc[q >> 2][0][q & 3][0] *= rs[q]; acc[q >> 2][0][q & 3][1] *= rs[q]; acc[q >> 2][1][q & 3][0] *= rs[q]; acc[q >> 2][1][q & 3][1] *= rs[q]; }
        GAS float* rawg = ssq_out + (size_t)(2 * u.pm + wr) * 4 * NUP + jc;
        GAS float* dumw = (GAS float*)out_k + (size_t)(blockIdx.x * 8 + wid) * 32;
        { GAS float* pg = (fr < 2) ? rawg + fr * NUP : dumw; GAS float* pu = (fr < 2) ? pg + DFF : dumw + 16;
          *(GAS f32x4*)pg = acc[0][0][0][0]; *(GAS f32x4*)(pg + 4) = acc[0][0][0][1]; *(GAS f32x4*)pu = acc[0][1][0][0]; *(GAS f32x4*)(pu + 4) = acc[0][1][0][1]; }
        { GAS float* pg = (fr >= 14) ? rawg + (fr - 12) * NUP : dumw; GAS float* pu = (fr >= 14) ? pg + DFF : dumw + 16;
          *(GAS f32x4*)pg = acc[1][0][3][0]; *(GAS f32x4*)(pg + 4) = acc[1][0][3][1]; *(GAS f32x4*)pu = acc[1][1][3][0]; *(GAS f32x4*)(pu + 4) = acc[1][1][3][1]; }
        asm volatile("" ::: "memory");
        const bool f1 = fr >= 1, f2 = fr >= 2;
#pragma unroll
        for (int n = 0; n < 2; ++n) {
            unsigned ow[8][2];
#pragma unroll
            for (int kp = 0; kp < 2; ++kp) {
                const LAS float* Pc = P + 8 * fq + 4 * n + 2 * kp;
                const f32x2_t wg0 = *(const LAS f32x2_t*)(Pc), wg1 = *(const LAS f32x2_t*)(Pc + 32), wg2 = *(const LAS f32x2_t*)(Pc + 64);
                const f32x2_t wu0 = *(const LAS f32x2_t*)(Pc + 96), wu1 = *(const LAS f32x2_t*)(Pc + 128), wu2 = *(const LAS f32x2_t*)(Pc + 160);
                const f32x2_t bg = *(const LAS f32x2_t*)(Pc + 192), bu = *(const LAS f32x2_t*)(Pc + 224);
                float r0[8];
#pragma unroll
                for (int kk = 0; kk < 2; ++kk) {
                    const int k = 2 * kp + kk;
                    float g1p = 0.f, g2p = 0.f, u1p = 0.f, u2p = 0.f;
#pragma unroll
                    for (int q = 0; q < 8; ++q) {
                        const float g = acc[q >> 2][0][q & 3][n][k], uu = acc[q >> 2][1][q & 3][n][k];
                        const float g1 = dpp_ror1(g), g2 = dpp_ror2(g), u1 = dpp_ror1(uu), u2 = dpp_ror2(uu);
                        const float pg1 = f1 ? g1 : g1p, pg2 = f2 ? g2 : g2p, pu1 = f1 ? u1 : u1p, pu2 = f2 ? u2 : u2p;
                        const float cg = bg[kk] + wg0[kk] * pg2 + wg1[kk] * pg1 + wg2[kk] * g;
                        const float cu = bu[kk] + wu0[kk] * pu2 + wu1[kk] * pu1 + wu2[kk] * uu;
                        const float res = cg * fast_sigmoid(cg) * cu;
                        if (kk == 0) r0[q] = res; else ow[q][kp] = pk2(r0[q], res);
                        g1p = g1; g2p = g2; u1p = u1; u2p = u2;
                    }
                }
                asm volatile("" ::: "memory");
            }
#pragma unroll
            for (int q = 0; q < 8; ++q) { v2u w; w.x = ow[q][0]; w.y = ow[q][1]; *(GAS v2u*)(out + (size_t)(tok0 + 16 * q + fr) * DFF + jc + 4 * n) = w; }
            asm volatile("" ::: "memory");
        }
    }
    __device__ __forceinline__ void operator()(f32x4 (&acc)[2][2][4][2], const Unit& u, int wr, int wc, int fr, int fq) const {
        if (MK_REP_MASK != 0u && skip) return;
        if (mode == EM_UPCONV) { upconv(acc, u, wr, wc, fr, fq); return; }
        const int row0 = u.pm * 256 + wr * 64 + fr;
        const int colt = u.pn * 256, cw = wc * 32 + 8 * fq;
        GAS bf16* obase = out; int old = ldo, ocol = colt;
        if (mode == EM_QKV) { if (u.pn == 4) { obase = out_k; old = 256; ocol = 0; } else if (u.pn == 5) { obase = out_v; old = 256; ocol = 0; } }
        const bool use_rs = (mode == EM_GELU) | (mode == EM_SCALE) | (mode == EM_GATE) | (mode == EM_QKV);
        const bool do_ssq = (mode == EM_RES) | (mode == EM_GATE) | ((mode == EM_GELU) & (u.pn >= 4));
        const unsigned slotbase = (unsigned)((mode == EM_GELU) ? (u.pn - 4) : u.pn) * (unsigned)T;
        float rsv[8];
        if (use_rs) wave_rstd8<false>(ssq_in, row0, fq, rsv);
        else {
#pragma unroll
            for (int q = 0; q < 8; ++q) rsv[q] = 1.0f; }
        LAS float* Pb = par + (wr * 4 + wc) * 256;
        if (mode == EM_GATE) {
            const int l16 = fq * 16 + fr;
            if (l16 < 16) *(LAS f32x4*)(Pb + (l16 >> 3) * 32 + 4 * (l16 & 7)) = *(const GAS f32x4*)(bias + colt + (l16 >> 3) * 128 + wc * 32 + 4 * (l16 & 7));
        }
#pragma unroll
        for (int aq = 0; aq < 4; ++aq) {
            const int ai = aq >> 1, m0 = (aq & 1) * 2;
            v4u rr[2][2], ee[2][2];
            if ((mode == EM_RES) | (mode == EM_GATE)) {
#pragma unroll
                for (int mm = 0; mm < 2; ++mm)
#pragma unroll
                    for (int bj = 0; bj < 2; ++bj) rr[mm][bj] = *(const GAS v4u*)(res + ((unsigned)(row0 + ai * 128 + (m0 + mm) * 16) * 1024u + (unsigned)(colt + bj * 128 + cw)));
            }
            if (mode == EM_GATE) {
#pragma unroll
                for (int mm = 0; mm < 2; ++mm)
#pragma unroll
                    for (int bj = 0; bj < 2; ++bj) ee[mm][bj] = *(const GAS v4u*)(pe + ((unsigned)(row0 + ai * 128 + (m0 + mm) * 16) * 1024u + (unsigned)(colt + bj * 128 + cw)));
            }
            __builtin_amdgcn_sched_barrier(0);
#pragma unroll
            for (int mm = 0; mm < 2; ++mm) {
                const int m = m0 + mm;
                const unsigned row = (unsigned)(row0 + ai * 128 + m * 16);
                const float rs = rsv[ai * 4 + m];
                float sq = 0.f;
#pragma unroll
                for (int bj = 0; bj < 2; ++bj) {
                    f32x4 v0 = acc[ai][bj][m][0] * rs, v1 = acc[ai][bj][m][1] * rs;
                    if (mode == EM_GELU) {
#pragma unroll
                        for (int j = 0; j < 4; ++j) { v0[j] = gelu_tanh(v0[j]); v1[j] = gelu_tanh(v1[j]); }
                    } else if (mode == EM_RES) {
                        const v4u r = rr[mm][bj];
                        v0[0] += bflo(r.x); v0[1] += bfhi(r.x); v0[2] += bflo(r.y); v0[3] += bfhi(r.y);
                        v1[0] += bflo(r.z); v1[1] += bfhi(r.z); v1[2] += bflo(r.w); v1[3] += bfhi(r.w);
                    } else if (mode == EM_GATE) {
                        const v4u r = rr[mm][bj], e = ee[mm][bj];
                        const f32x4 b0 = *(const LAS f32x4*)(Pb + bj * 32 + 8 * fq), b1 = *(const LAS f32x4*)(Pb + bj * 32 + 8 * fq + 4);
                        v0[0] = bflo(r.x) + bflo(e.x) * fast_sigmoid(v0[0] + b0[0]); v0[1] = bfhi(r.x) + bfhi(e.x) * fast_sigmoid(v0[1] + b0[1]);
                        v0[2] = bflo(r.y) + bflo(e.y) * fast_sigmoid(v0[2] + b0[2]); v0[3] = bfhi(r.y) + bfhi(e.y) * fast_sigmoid(v0[3] + b0[3]);
                        v1[0] = bflo(r.z) + bflo(e.z) * fast_sigmoid(v1[0] + b1[0]); v1[1] = bfhi(r.z) + bfhi(e.z) * fast_sigmoid(v1[1] + b1[1]);
                        v1[2] = bflo(r.w) + bflo(e.w) * fast_sigmoid(v1[2] + b1[2]); v1[3] = bfhi(r.w) + bfhi(e.w) * fast_sigmoid(v1[3] + b1[3]);
                    }
                    sq += (v0[0] * v0[0] + v0[1] * v0[1]) + (v0[2] * v0[2] + v0[3] * v0[3]) + (v1[0] * v1[0] + v1[1] * v1[1]) + (v1[2] * v1[2] + v1[3] * v1[3]);
                    v4u w; w.x = pk2(v0[0], v0[1]); w.y = pk2(v0[2], v0[3]); w.z = pk2(v1[0], v1[1]); w.w = pk2(v1[2], v1[3]);
                    *(GAS v4u*)(obase + (row * (unsigned)old + (unsigned)(ocol + bj * 128 + cw))) = w;
                }
                if (do_ssq) {
                    sq += __shfl_xor(sq, 16); sq += __shfl_xor(sq, 32);
                    if (fq == 0) ssq_out[(slotbase + row) * 4u + (unsigned)wc] = sq;
                }
            }
            __builtin_amdgcn_sched_barrier(0);
        }
    }
};

__device__ __forceinline__ void transpose_item(const GAS float* W, int K, int N, GAS bf16* WT, int row_off, const GAS float* gain, LAS float* scr, int item, int lane, bool upperm) {
    const int nblk = N / 32, kb = item / nblk, nb = item % nblk, k0 = 64 * kb, n0 = 32 * nb;
    int r0 = row_off + n0;
    if (upperm) { const int bj = (n0 >= DFF) ? 1 : 0, ci = n0 - DFF * bj; r0 = 256 * (ci >> 7) + 128 * bj + (ci & 127); }
#pragma unroll 16
    for (int i = 0; i < 32; ++i) { const int kk = 2 * i + (lane >> 5); const float gsc = gain ? gain[k0 + kk] : 1.0f; scr[kk * 33 + (lane & 31)] = W[(size_t)(k0 + kk) * N + n0 + (lane & 31)] * gsc; }
    asm volatile("s_waitcnt lgkmcnt(0)" ::: "memory");
    const int c = lane & 7;
#pragma unroll
    for (int j = 0; j < 4; ++j) { const int n = (lane >> 3) + 8 * j; const LAS float* s = scr + (8 * c) * 33 + n;
        v4u o; o.x = pk2(s[0 * 33], s[1 * 33]); o.y = pk2(s[2 * 33], s[3 * 33]); o.z = pk2(s[4 * 33], s[5 * 33]); o.w = pk2(s[6 * 33], s[7 * 33]);
        *(GAS v4u*)(WT + (size_t)(r0 + n) * K + k0 + 8 * c) = o; }
    asm volatile("s_waitcnt lgkmcnt(0)" ::: "memory");
}

__device__ __forceinline__ void prologue(PTT PT, LAS unsigned char* lds) {
    const int tid = opaque_tid(), bid = opaque_bid(), lane = tid & 63, wave = tid >> 6;
    const int gw = bid * 8 + wave, NGW = gridDim.x * 8;
    LAS float* scr = (LAS float*)(lds + wave * 16384);
    GAS unsigned char* ws = WSP;
    if (wave & 1) {
        const int tw = bid * 4 + (wave >> 1), NTW = gridDim.x * 4;
        for (int gi = tw; gi < 12544; gi += NTW) {
            const GAS float* W; int K, N, ro = 0, it = gi, mi; GAS bf16* WT; const GAS float* gain = nullptr;
            if (gi < 1024) { mi = 0; W = INP(7); K = 1024; N = 2048; WT = (GAS bf16*)(ws + WS_WIN); gain = INP(2); }
            else if (gi < 1536) { mi = 1; it = gi - 1024; W = INP(11); K = 1024; N = 1024; WT = (GAS bf16*)(ws + WS_WOUT); }
            else if (gi < 2048) { mi = 2; it = gi - 1536; W = INP(13); K = 1024; N = 1024; WT = (GAS bf16*)(ws + WS_WQKV); gain = INP(2) + 1024; }
            else if (gi < 2304) { mi = 3; it = gi - 2048; W = INP(12); K = 1024; N = 512; WT = (GAS bf16*)(ws + WS_WQKV); ro = 1024; gain = INP(5); }
            else if (gi < 2816) { mi = 4; it = gi - 2304; W = INP(15); K = 1024; N = 1024; WT = (GAS bf16*)(ws + WS_WO); }
            else if (gi < 5632) { mi = 5; it = gi - 2816; W = INP(16); K = 1024; N = NUP; WT = (GAS bf16*)(ws + WS_WUP); gain = INP(3); }
            else if (gi < 8448) { mi = 6; it = gi - 5632; W = INP(16) + (size_t)1024 * NUP; K = 1024; N = NUP; WT = (GAS bf16*)(ws + WS_WUP) + (size_t)NUP * 1024; gain = INP(3) + 1024; }
            else if (gi < 9856) { mi = 7; it = gi - 8448; W = INP(19); K = DFF; N = 1024; WT = (GAS bf16*)(ws + WS_WDN); }
            else if (gi < 11264) { mi = 8; it = gi - 9856; W = INP(19) + (size_t)DFF * 1024; K = DFF; N = 1024; WT = (GAS bf16*)(ws + WS_WDN) + (size_t)1024 * DFF; }
            else if (gi < 11392) { mi = 9; it = gi - 11264; W = INP(20); K = 256; N = 1024; WT = (GAS bf16*)(ws + WS_WPE); }
            else if (gi < 11520) { mi = 10; it = gi - 11392; W = INP(20) + (size_t)256 * 1024; K = 256; N = 1024; WT = (GAS bf16*)(ws + WS_WPE) + (size_t)1024 * 256; }
            else if (gi < 12032) { mi = 11; it = gi - 11520; W = INP(21); K = 1024; N = 1024; WT = (GAS bf16*)(ws + WS_WG); gain = INP(4); }
            else { mi = 12; it = gi - 12032; W = INP(21) + (size_t)1024 * 1024; K = 1024; N = 1024; WT = (GAS bf16*)(ws + WS_WG) + (size_t)1024 * 1024; gain = INP(4) + 1024; }
            transpose_item(W, K, N, WT, ro, gain, scr, it, lane, mi == 5 || mi == 6);
        }
    }
    {
        const GAS float* w = INP(9); GAS bf16* o = (GAS bf16*)(ws + WS_WS);
        for (int i = bid * 512 + tid; i < 8 * 128 * 128; i += gridDim.x * 512) { const int s = i & 127, t = (i >> 7) & 127; o[i] = (bf16)f2bf(s <= t ? w[i] : 0.0f); }
    }
    {
        const GAS float* x = INP(0); GAS bf16* xb = (GAS bf16*)(ws + WS_HA); GAS float* ssq0 = (GAS float*)(ws + WS_SSQ);
        if (!(wave & 1))
#pragma unroll 8
        for (int r = bid * 4 + (wave >> 1); r < T; r += gridDim.x * 4) {
            const GAS f32x4* xr = (const GAS f32x4*)(x + (size_t)r * D) + lane; float s = 0.f;
            GAS unsigned long long* o8 = (GAS unsigned long long*)(xb + (size_t)r * D) + lane;
#pragma unroll
            for (int j = 0; j < 4; ++j) { const f32x4 v = xr[64 * j]; s += (v[0] * v[0] + v[1] * v[1]) + (v[2] * v[2] + v[3] * v[3]);
                o8[64 * j] = (unsigned long long)pk2(v[0], v[1]) | ((unsigned long long)pk2(v[2], v[3]) << 32); }
            s = wave_sum(s);
            if (lane < 16) ssq0[((size_t)(lane >> 2) * T + (size_t)r) * 4 + (lane & 3)] = (lane == 0) ? s : 0.f;
        }
    }
    {
        const GAS f32x4* p4 = (const GAS f32x4*)INP(1); GAS unsigned long long* o8 = (GAS unsigned long long*)(ws + WS_PB);
        const size_t n4 = (size_t)2 * T * 256 / 4;
#pragma unroll 8
        for (size_t i = (size_t)bid * 512 + tid; i < n4; i += (size_t)gridDim.x * 512) { const f32x4 v = p4[i]; o8[i] = (unsigned long long)pk2(v[0], v[1]) | ((unsigned long long)pk2(v[2], v[3]) << 32); }
    }
}

__device__ __forceinline__ void spatial_phase(PTT PT, LAS unsigned char* lds) {
    const int tid = opaque_tid(), bid = opaque_bid(), lane = tid & 63, wave = __builtin_amdgcn_readfirstlane(tid >> 6), r = lane & 31, hh = lane >> 5;
    GAS unsigned char* ws = WSP;
    const GAS bf16* z = (const GAS bf16*)(ws + WS_BIG); GAS bf16* us = (GAS bf16*)(ws + WS_BIG + 256 * MiB);
    const GAS float* ssq1 = (const GAS float*)(ws + WS_SSQ + 1 * 4 * MiB);
    const GAS bf16* Wsb = (const GAS bf16*)(ws + WS_WS);
    const GAS float* gv = INP(8); const GAS float* bs = INP(10);
    LAS unsigned* vT32 = (LAS unsigned*)lds;
    LAS unsigned char* vTb = lds;
    const int tt = wave >> 1, dd0 = (wave & 1) * 2, p = tid & 63;
    int hcur = -1; bf16x8 af[8]; float biasv[16]; f32x4 gg[2][2];
    v4u nva[2], nvb[2]; float nrsa = 0.f, nrsb = 0.f;
#define SP_FETCH(UU) do { const int h_ = (UU) & 7, c_ = (UU) >> 3; const size_t ra_ = (size_t)c_ * 128 + 2 * p, rb_ = ra_ + 1; \
        nrsa = row_rstd(ssq1, ra_); nrsb = row_rstd(ssq1, rb_); \
        _Pragma("unroll") for (int it = 0; it < 2; ++it) { const int cc = (tid >> 6) + 8 * it; \
            nva[it] = *(const GAS v4u*)(z + ra_ * 2048 + 1024 + h_ * 128 + cc * 8); nvb[it] = *(const GAS v4u*)(z + rb_ * 2048 + 1024 + h_ * 128 + cc * 8); } } while (0)
    if (bid < 4096) SP_FETCH(bid);
    for (int u = bid; u < 4096; u += gridDim.x) {
        const int h = u & 7, c = u >> 3; const size_t tok0 = (size_t)c * 128;
        if (h != hcur) {
            hcur = h;
            const GAS bf16* wrow = Wsb + ((size_t)(h * 128 + 32 * tt + r)) * 128 + 8 * hh;
#pragma unroll
            for (int ks = 0; ks < 8; ++ks) af[ks] = *(const GAS bf16x8*)(wrow + 16 * ks);
#pragma unroll
            for (int reg = 0; reg < 16; ++reg) biasv[reg] = bs[h * 128 + 32 * tt + (reg & 3) + 8 * (reg >> 2) + 4 * hh];
#pragma unroll
            for (int it = 0; it < 2; ++it) { const int cc = (tid >> 6) + 8 * it; gg[it][0] = *(const GAS f32x4*)(gv + h * 128 + cc * 8); gg[it][1] = *(const GAS f32x4*)(gv + h * 128 + cc * 8 + 4); }
        }
        __syncthreads();
#pragma unroll
        for (int it = 0; it < 2; ++it) {
            const int cc = (tid >> 6) + 8 * it;
            const v4u va = nva[it], vb = nvb[it]; const f32x4 g0 = gg[it][0], g1 = gg[it][1]; const float rsa = nrsa, rsb = nrsb;
            LAS unsigned* dst = vT32 + (cc * 8) * 68 + p;
            dst[0 * 68] = pk2(bflo(va.x) * rsa * g0[0], bflo(vb.x) * rsb * g0[0]);
            dst[1 * 68] = pk2(bfhi(va.x) * rsa * g0[1], bfhi(vb.x) * rsb * g0[1]);
            dst[2 * 68] = pk2(bflo(va.y) * rsa * g0[2], bflo(vb.y) * rsb * g0[2]);
            dst[3 * 68] = pk2(bfhi(va.y) * rsa * g0[3], bfhi(vb.y) * rsb * g0[3]);
            dst[4 * 68] = pk2(bflo(va.z) * rsa * g1[0], bflo(vb.z) * rsb * g1[0]);
            dst[5 * 68] = pk2(bfhi(va.z) * rsa * g1[1], bfhi(vb.z) * rsb * g1[1]);
            dst[6 * 68] = pk2(bflo(va.w) * rsa * g1[2], bflo(vb.w) * rsb * g1[2]);
            dst[7 * 68] = pk2(bfhi(va.w) * rsa * g1[3], bfhi(vb.w) * rsb * g1[3]);
        }
        __syncthreads();
        if (u + (int)gridDim.x < 4096) SP_FETCH(u + (int)gridDim.x);
        bf16 uv0[16], uv1[16];
#pragma unroll
        for (int reg = 0; reg < 16; ++reg) { const size_t tok = tok0 + 32 * tt + (reg & 3) + 8 * (reg >> 2) + 4 * hh; const int ch = h * 128 + 32 * dd0 + r;
            uv0[reg] = z[tok * 2048 + ch]; uv1[reg] = z[tok * 2048 + ch + 32]; }
        f32x16 acc0, acc1;
#pragma unroll
        for (int i = 0; i < 16; ++i) { acc0[i] = 0.f; acc1[i] = 0.f; }
        const LAS unsigned char* b0p = vTb + (32 * dd0 + r) * 272 + 16 * hh, * b1p = b0p + 32 * 272;
        const int nks = 2 * tt + 2;
#pragma unroll
        for (int ks = 0; ks < 8; ++ks) {
            if (ks < nks) {
                const bf16x8 bf0 = *(const LAS bf16x8*)(b0p + 32 * ks), bf1 = *(const LAS bf16x8*)(b1p + 32 * ks);
                acc0 = __builtin_amdgcn_mfma_f32_32x32x16_bf16(af[ks], bf0, acc0, 0, 0, 0);
                acc1 = __builtin_amdgcn_mfma_f32_32x32x16_bf16(af[ks], bf1, acc1, 0, 0, 0);
            }
        }
#pragma unroll
        for (int reg = 0; reg < 16; ++reg) {
            const int t = 32 * tt + (reg & 3) + 8 * (reg >> 2) + 4 * hh;
            const size_t tok = tok0 + t; const int ch = h * 128 + 32 * dd0 + r;
            const float u0 = bf2f(uv0[reg]), u1 = bf2f(uv1[reg]);
            us[tok * 1024 + ch] = (bf16)f2bf(u0 * (acc0[reg] + biasv[reg]));
            us[tok * 1024 + ch + 32] = (bf16)f2bf(u1 * (acc1[reg] + biasv[reg]));
        }
    }
#undef SP_FETCH
}

__device__ __forceinline__ void fix_phase(const GAS float* raw, GAS bf16* act, const GAS float* cw, const GAS float* cb) {
    constexpr int NC4 = DFF / 4;
    const int nitems = 512 * NC4;
    for (int it = opaque_bid() * 512 + opaque_tid(); it < nitems; it += gridDim.x * 512) {
        const int grp = it / NC4, c4 = (it % NC4) * 4;
        const f32x4 wg0 = *(const GAS f32x4*)(cw + c4), wg1 = *(const GAS f32x4*)(cw + NUP + c4), wg2 = *(const GAS f32x4*)(cw + 2 * NUP + c4);
        const f32x4 wu0 = *(const GAS f32x4*)(cw + DFF + c4), wu1 = *(const GAS f32x4*)(cw + NUP + DFF + c4), wu2 = *(const GAS f32x4*)(cw + 2 * NUP + DFF + c4);
        const f32x4 bg = *(const GAS f32x4*)(cb + c4), bu = *(const GAS f32x4*)(cb + DFF + c4);
        const GAS float* rc = raw + (size_t)grp * 4 * NUP + c4;
        const f32x4 g0 = *(const GAS f32x4*)(rc), u0 = *(const GAS f32x4*)(rc + DFF), g1 = *(const GAS f32x4*)(rc + NUP), u1 = *(const GAS f32x4*)(rc + NUP + DFF);
        f32x4 gm2 = {0.f, 0.f, 0.f, 0.f}, gm1 = gm2, um2 = gm2, um1 = gm2;
        if ((grp & 63) != 0) { const GAS float* rp = rc - 4 * NUP; gm2 = *(const GAS f32x4*)(rp + 2 * NUP); um2 = *(const GAS f32x4*)(rp + 2 * NUP + DFF); gm1 = *(const GAS f32x4*)(rp + 3 * NUP); um1 = *(const GAS f32x4*)(rp + 3 * NUP + DFF); }
        float a0[4], a1[4];
#pragma unroll
        for (int k = 0; k < 4; ++k) {
            const float cg0 = bg[k] + wg0[k] * gm2[k] + wg1[k] * gm1[k] + wg2[k] * g0[k], cu0 = bu[k] + wu0[k] * um2[k] + wu1[k] * um1[k] + wu2[k] * u0[k];
            const float cg1 = bg[k] + wg0[k] * gm1[k] + wg1[k] * g0[k] + wg2[k] * g1[k], cu1 = bu[k] + wu0[k] * um1[k] + wu1[k] * u0[k] + wu2[k] * u1[k];
            a0[k] = cg0 * fast_sigmoid(cg0) * cu0; a1[k] = cg1 * fast_sigmoid(cg1) * cu1;
        }
        v2u w0, w1; w0.x = pk2(a0[0], a0[1]); w0.y = pk2(a0[2], a0[3]); w1.x = pk2(a1[0], a1[1]); w1.y = pk2(a1[2], a1[3]);
        GAS bf16* ar = act + (size_t)grp * 128 * DFF + c4;
        *(GAS v2u*)ar = w0; *(GAS v2u*)(ar + DFF) = w1;
    }
}

__device__ __forceinline__ void attn_phase(PTT PT, LAS unsigned char* lds) {
    const int tid = opaque_tid(), bid = opaque_bid(), lane = tid & 63, wave = __builtin_amdgcn_readfirstlane(tid >> 6), r = lane & 31, hh = lane >> 5;
    GAS unsigned char* ws = WSP;
    const GAS bf16* qb = (const GAS bf16*)(ws + WS_BIG); const GAS bf16* kb = (const GAS bf16*)(ws + WS_BIG + 128 * MiB); const GAS bf16* vb = (const GAS bf16*)(ws + WS_BIG + 160 * MiB);
    GAS bf16* ao = (GAS bf16*)(ws + WS_BIG + 192 * MiB);
    const GAS float* sinks = INP(14);
    LAS unsigned char* Ks = lds;
    LAS unsigned* Vt32 = (LAS unsigned*)(lds + 36864);
    LAS unsigned char* Vtb = lds + 36864;
    v4u kreg[4], vreg[2][2]; bf16x8 qn[2][4];
#define ATTN_FETCH(UU) do { const int kvh_ = (UU) & 3, nb_ = ((UU) >> 2) & 63, b_ = (UU) >> 8; const long t0_ = (long)b_ * SEQ + (long)nb_ * 128; \
        _Pragma("unroll") for (int it = 0; it < 4; ++it) { const int idx = tid + 512 * it, row = idx >> 3, c = idx & 7; const long tok = t0_ - 128 + row; \
            v4u val = {0u, 0u, 0u, 0u}; if (nb_ > 0 || row >= 128) val = *(const GAS v4u*)(kb + tok * 256 + kvh_ * 64 + c * 8); kreg[it] = val; } \
        _Pragma("unroll") for (int it = 0; it < 2; ++it) { const int p = tid & 127, c = (tid >> 7) + 4 * it; const long tok = t0_ - 128 + 2 * p; \
            v4u va = {0u, 0u, 0u, 0u}, vbv = va; if (nb_ > 0 || p >= 64) { va = *(const GAS v4u*)(vb + tok * 256 + kvh_ * 64 + c * 8); vbv = *(const GAS v4u*)(vb + (tok + 1) * 256 + kvh_ * 64 + c * 8); } \
            vreg[it][0] = va; vreg[it][1] = vbv; } \
        _Pragma("unroll") for (int i_ = 0; i_ < 2; ++i_) { const int wu_ = wave + 8 * i_; const GAS bf16* qrow_ = qb + (size_t)(t0_ + 32 * (wu_ >> 2) + r) * 1024 + (kvh_ * 4 + (wu_ & 3)) * 64 + 8 * hh; \
            _Pragma("unroll") for (int ks = 0; ks < 4; ++ks) qn[i_][ks] = *(const GAS bf16x8*)(qrow_ + 16 * ks); } } while (0)
    if (bid < 2048) ATTN_FETCH(bid);
    for (int u = bid; u < 2048; u += gridDim.x) {
        const int kvh = u & 3, nb = (u >> 2) & 63, b = u >> 8;
        const long t0 = (long)b * SEQ + (long)nb * 128;
        __syncthreads();
#pragma unroll
        for (int it = 0; it < 4; ++it) { const int idx = tid + 512 * it, row = idx >> 3, c = idx & 7; *(LAS v4u*)(Ks + row * 144 + c * 16) = kreg[it]; }
#pragma unroll
        for (int it = 0; it < 2; ++it) {
            const int p = tid & 127, c = (tid >> 7) + 4 * it; const v4u va = vreg[it][0], vbv = vreg[it][1];
            LAS unsigned* dst = Vt32 + (c * 8) * 130 + p;
            dst[0 * 130] = (va.x & 0xffffu) | (vbv.x << 16); dst[1 * 130] = (va.x >> 16) | (vbv.x & 0xffff0000u);
            dst[2 * 130] = (va.y & 0xffffu) | (vbv.y << 16); dst[3 * 130] = (va.y >> 16) | (vbv.y & 0xffff0000u);
            dst[4 * 130] = (va.z & 0xffffu) | (vbv.z << 16); dst[5 * 130] = (va.z >> 16) | (vbv.z & 0xffff0000u);
            dst[6 * 130] = (va.w & 0xffffu) | (vbv.w << 16); dst[7 * 130] = (va.w >> 16) | (vbv.w & 0xffff0000u);
        }
        __syncthreads();
        bf16x8 qc[2][4];
#pragma unroll
        for (int i = 0; i < 2; ++i)
#pragma unroll
            for (int ks = 0; ks < 4; ++ks) qc[i][ks] = qn[i][ks];
        if (u + (int)gridDim.x < 2048) ATTN_FETCH(u + (int)gridDim.x);
#pragma unroll
        for (int i = 0; i < 2; ++i) {
            const int wu = wave + 8 * i, g = wu & 3, qt = wu >> 2, head = kvh * 4 + g, i0 = 32 * qt;
            bf16x8 qf[4];
#pragma unroll
            for (int ks = 0; ks < 4; ++ks) qf[ks] = qc[i][ks];
            const float slope = exp2f(-0.5f * (float)(head + 1)), sink = sinks[head];
            const int kk_lo = (nb > 0) ? 0 : ((qt < 4) ? 4 - qt : 0);
            float mx = sink;
#pragma unroll 1
            for (int kk = kk_lo; kk < 5; ++kk) {
                f32x16 sc;
#pragma unroll
                for (int e = 0; e < 16; ++e) sc[e] = 0.f;
                const LAS unsigned char* kp = Ks + (32 * (qt + kk) + r) * 144 + 16 * hh;
#pragma unroll
                for (int ks = 0; ks < 4; ++ks) { const bf16x8 kf = *(const LAS bf16x8*)(kp + 32 * ks); sc = __builtin_amdgcn_mfma_f32_32x32x16_bf16(kf, qf[ks], sc, 0, 0, 0); }
                const int rdk = r + 128 - 32 * kk - 4 * hh;
#pragma unroll
                for (int e = 0; e < 16; ++e) {
                    const int dist = rdk - ((e & 3) + 8 * (e >> 2));
                    const float sv = fmaf(-slope, (float)dist, sc[e] * 0.125f);
                    mx = ((unsigned)dist < 128u) ? fmaxf(mx, sv) : mx;
                }
            }
            mx = fmaxf(mx, __shfl_xor(mx, 32));
            float sum = 0.f;
            f32x16 o0, o1;
#pragma unroll
            for (int e = 0; e < 16; ++e) { o0[e] = 0.f; o1[e] = 0.f; }
#pragma unroll 1
            for (int kk = kk_lo; kk < 5; ++kk) {
                f32x16 sc;
#pragma unroll
                for (int e = 0; e < 16; ++e) sc[e] = 0.f;
                const LAS unsigned char* kp = Ks + (32 * (qt + kk) + r) * 144 + 16 * hh;
#pragma unroll
                for (int ks = 0; ks < 4; ++ks) { const bf16x8 kf = *(const LAS bf16x8*)(kp + 32 * ks); sc = __builtin_amdgcn_mfma_f32_32x32x16_bf16(kf, qf[ks], sc, 0, 0, 0); }
                const int rdk = r + 128 - 32 * kk - 4 * hh;
#pragma unroll
                for (int e = 0; e < 16; ++e) {
                    const int dist = rdk - ((e & 3) + 8 * (e >> 2));
                    const float sv = fmaf(-slope, (float)dist, sc[e] * 0.125f);
                    const float ev = ((unsigned)dist < 128u) ? __expf(sv - mx) : 0.f;
                    sc[e] = ev; sum += ev;
                }
#pragma unroll
                for (int s2 = 0; s2 < 2; ++s2) {
                    v4u pw;
                    pw.x = pk2(sc[8 * s2 + 0], sc[8 * s2 + 1]); pw.y = pk2(sc[8 * s2 + 2], sc[8 * s2 + 3]);
                    pw.z = pk2(sc[8 * s2 + 4], sc[8 * s2 + 5]); pw.w = pk2(sc[8 * s2 + 6], sc[8 * s2 + 7]);
                    const bf16x8 pa = __builtin_bit_cast(bf16x8, pw);
                    const int key0 = 32 * (qt + kk) + 16 * s2 + 4 * hh;
                    const LAS unsigned char* v0p = Vtb + r * 520 + key0 * 2, * v1p = v0p + 32 * 520;
                    const v2u x0 = *(const LAS v2u*)(v0p), x1 = *(const LAS v2u*)(v0p + 16), y0 = *(const LAS v2u*)(v1p), y1 = *(const LAS v2u*)(v1p + 16);
                    v4u vw0, vw1; vw0.x = x0.x; vw0.y = x0.y; vw0.z = x1.x; vw0.w = x1.y; vw1.x = y0.x; vw1.y = y0.y; vw1.z = y1.x; vw1.w = y1.y;
                    o0 = __builtin_amdgcn_mfma_f32_32x32x16_bf16(pa, __builtin_bit_cast(bf16x8, vw0), o0, 0, 0, 0);
                    o1 = __builtin_amdgcn_mfma_f32_32x32x16_bf16(pa, __builtin_bit_cast(bf16x8, vw1), o1, 0, 0, 0);
                }
            }
            sum += __shfl_xor(sum, 32);
            const float inv = 1.0f / (sum + __expf(sink - mx));
#pragma unroll
            for (int e = 0; e < 16; ++e) {
                const int qr = (e & 3) + 8 * (e >> 2) + 4 * hh;
                const float ie = __shfl(inv, qr);
                GAS bf16* orow = ao + (size_t)(t0 + i0 + qr) * 1024 + head * 64 + r;
                orow[0] = (bf16)f2bf(o0[e] * ie); orow[32] = (bf16)f2bf(o1[e] * ie);
            }
        }
    }
#undef ATTN_FETCH
}

__device__ __forceinline__ void final_phase(PTT PT) {
    const int tid = opaque_tid(), lane = tid & 63, wave = tid >> 6;
    const int gw = opaque_bid() * 8 + wave, NGW = gridDim.x * 8;
    const GAS bf16* h = (const GAS bf16*)(WSP + WS_HA); const GAS float* ssq = (const GAS float*)(WSP + WS_SSQ + 7 * 4 * MiB); const GAS float* gf = INP(6);
    f32x4 g[4];
#pragma unroll
    for (int j = 0; j < 2; ++j) { g[2 * j] = *(const GAS f32x4*)(gf + 512 * j + lane * 8); g[2 * j + 1] = *(const GAS f32x4*)(gf + 512 * j + lane * 8 + 4); }
#if MK_DIAG
    float dA = 0.f; unsigned dM = 0;
    {
        const GAS unsigned long long* st = (const GAS unsigned long long*)(WSP + 4096);
        const float cyc = (float)st[2 * MK_DIAG_OP], us = (float)st[2 * MK_DIAG_OP + 1] * 0.01f, us2 = (float)st[2 * MK_DIAG_OP2 + 1] * 0.01f;
        if (MK_DIAG_MODE == 0) { dA = cyc / us * (1.0f / 100.0f); dM = (unsigned)(us * 1000.0f); }
        else { dA = us2 * (1.0f / 10.0f); dM = (unsigned)(us * 1000.0f); }
    }
#endif
#pragma unroll 8
    for (int r = gw; r < T; r += NGW) {
        const float rs = row_rstd(ssq, (size_t)r);
#pragma unroll
        for (int j = 0; j < 2; ++j) {
            const v4u w = *(const GAS v4u*)(h + (size_t)r * D + 512 * j + lane * 8);
            f32x4 o0, o1;
            o0[0] = bflo(w.x) * rs * g[2 * j][0]; o0[1] = bfhi(w.x) * rs * g[2 * j][1]; o0[2] = bflo(w.y) * rs * g[2 * j][2]; o0[3] = bfhi(w.y) * rs * g[2 * j][3];
            o1[0] = bflo(w.z) * rs * g[2 * j + 1][0]; o1[1] = bfhi(w.z) * rs * g[2 * j + 1][1]; o1[2] = bflo(w.w) * rs * g[2 * j + 1][2]; o1[3] = bfhi(w.w) * rs * g[2 * j + 1][3];
#if MK_DIAG
            { const unsigned e0 = (unsigned)r * 1024u + 512u * j + lane * 8u;
#pragma unroll
              for (int k = 0; k < 4; ++k) { if (e0 + k < dM) o0[k] += 1.0f; if (e0 + 4 + k < dM) o1[k] += 1.0f; }
              if (e0 == 0) o0[0] += dA; }
#endif
            GAS float* op = OUTP + (size_t)r * D + 512 * j + lane * 8;
            *(GAS f32x4*)op = o0; *(GAS f32x4*)(op + 4) = o1;
        }
    }
}

#define XB_TMO      128
#define XB_XCNT(j)  (256  + 64 * (j))
#define XB_XSUB(j)  (1280 + 64 * (j))
#define XB_XGEN(j)  (2304 + 64 * (j))
#define XB_TOP      3328
#define XB_TOPGEN   3392
#define XCD_BAR_WORDS 3456
#define XB_SPIN_CAP (1u << 18)

__device__ __forceinline__ unsigned xb_ld(unsigned* p)              { return __hip_atomic_load(p, __ATOMIC_RELAXED, __HIP_MEMORY_SCOPE_AGENT); }
__device__ __forceinline__ unsigned xb_add(unsigned* p, unsigned v) { return __hip_atomic_fetch_add(p, v, __ATOMIC_RELAXED, __HIP_MEMORY_SCOPE_AGENT); }
__device__ __forceinline__ unsigned xb_xcc_id() { return (unsigned)__builtin_amdgcn_s_getreg((3 << 11) | 20) & 0xFu; }
#define XB_SPIN(cond, bar) do { unsigned _sp = 0; while (cond) { __builtin_amdgcn_s_sleep(1); \
    if ((++_sp & 255u) == 0u) { if (xb_ld(&(bar)[XB_TMO])) break; if (_sp > XB_SPIN_CAP) { atomicAdd(&(bar)[XB_TMO], 1u); break; } } } } while (0)

struct XcdBarrier {
    unsigned* bar; unsigned x;
    volatile LAS unsigned* st;
};

__device__ __forceinline__ XcdBarrier xcd_barrier_post(unsigned* bar, volatile LAS unsigned* st) {
    XcdBarrier b; b.bar = bar; b.x = xb_xcc_id(); b.st = st;
    if (threadIdx.x == 0) (void)xb_add(&bar[XB_XCNT(b.x)], 1u);
    return b;
}
__device__ __forceinline__ void xcd_barrier_complete(unsigned* bar, unsigned x, unsigned& nloc, unsigned& nx) {
    const unsigned G = gridDim.x * gridDim.y * gridDim.z;
    unsigned sum, cnt, mine, sp = 0u;
    for (;;) {
        sum = 0u; cnt = 0u; mine = 0u;
#pragma unroll
        for (unsigned j = 0; j < 16; ++j) { const unsigned c = xb_ld(&bar[XB_XCNT(j)]); sum += c; cnt += (c > 0u) ? 1u : 0u; mine = (j == x) ? c : mine; }
        if (sum == G) break;
        __builtin_amdgcn_s_sleep(1);
        if ((++sp & 255u) == 0u) { if (xb_ld(&bar[XB_TMO])) break; if (sp > XB_SPIN_CAP) { atomicAdd(&bar[XB_TMO], 1u); break; } }
    }
    nloc = mine > 0u ? mine : 1u; nx = cnt > 0u ? cnt : 1u;
}

__device__ __forceinline__ void xcd_barrier(const XcdBarrier& b) {
    asm volatile("s_waitcnt vmcnt(0)" ::: "memory");
    __syncthreads();
    if (threadIdx.x == 0) {
        unsigned* bar = b.bar;
        __builtin_amdgcn_s_waitcnt(0);
        unsigned nloc = b.st[0], nx = b.st[1];
        if (nloc == 0u) { xcd_barrier_complete(bar, b.x, nloc, nx); b.st[0] = nloc; b.st[1] = nx; }
        const unsigned old = xb_add(&bar[XB_XSUB(b.x)], 1u);
        const unsigned gen = old / nloc;
        if (old + 1u == (gen + 1u) * nloc) {
            __builtin_amdgcn_fence(__ATOMIC_RELEASE, "agent");
            asm volatile("s_waitcnt vmcnt(0)" ::: "memory");
            const unsigned og = xb_add(&bar[XB_TOP], 1u);
            const unsigned tg = og / nx;
            if (og + 1u == (tg + 1u) * nx) xb_add(&bar[XB_TOPGEN], 1u);
            else XB_SPIN(xb_ld(&bar[XB_TOPGEN]) == tg, bar);
            __builtin_amdgcn_fence(__ATOMIC_ACQUIRE, "agent");
            xb_add(&bar[XB_XGEN(b.x)], 1u);
            asm volatile("s_waitcnt vmcnt(0)" ::: "memory");
        } else {
            XB_SPIN(xb_ld(&bar[XB_XGEN(b.x)]) == gen, bar);
            __builtin_amdgcn_fence(__ATOMIC_ACQUIRE, "agent");
            asm volatile("s_waitcnt vmcnt(0)" ::: "memory");
        }
    }
    __syncthreads();
}

enum { OP_PRO = 0, OP_GEMM = 1, OP_SPATIAL = 2, OP_FIX = 3, OP_ATTN = 4, OP_FINAL = 5 };
constexpr int N_OPS = 18;
__host__ __device__ inline int op_kind(int op) {
    switch (op) { case 0: return OP_PRO; case 2: return OP_SPATIAL; case 5: case 13: return OP_FIX; case 10: return OP_ATTN; case 17: return OP_FINAL; default: return OP_GEMM; }
}
__host__ __device__ inline bool op_sync_after(int op) { return !(op == 6 || op == 14 || op == 17); }

__device__ __forceinline__ void make_gemm(int op, PTT PT, pg8::Gemm& g, Epi& E) {
    GAS unsigned char* ws = WSP;
    GAS bf16* HA = (GAS bf16*)(ws + WS_HA); GAS bf16* HB = (GAS bf16*)(ws + WS_HB); GAS bf16* PE = (GAS bf16*)(ws + WS_PE); GAS bf16* BIG = (GAS bf16*)(ws + WS_BIG);
    GAS float* SSQ = (GAS float*)(ws + WS_SSQ); const size_t SS = (size_t)T * 16;
    GAS bf16* ACT = (GAS bf16*)(ws + WS_ACT);
    E.mode = EM_PLAIN; E.out = nullptr; E.ldo = 1024; E.res = nullptr; E.pe = nullptr; E.ssq_in = nullptr; E.ssq_out = nullptr; E.bias = nullptr; E.out_k = nullptr; E.out_v = nullptr; E.cw = nullptr; E.skip = 0; E.par = nullptr;
    g.A = (const pg8::bf16_t*)(nullptr); g.Bt = (const pg8::bf16_t*)(nullptr); g.M = T; g.N = 1024; g.K = 1024; g.aperm = 0;
    const int layer = (op >= 12) ? 1 : 0;
    switch (op) {
        case 1:  g.A = (const pg8::bf16_t*)(HA); g.Bt = (const pg8::bf16_t*)((const GAS bf16*)(ws + WS_WIN)); g.N = 2048; E.mode = EM_GELU; E.out = BIG; E.ldo = 2048; E.ssq_in = SSQ; E.ssq_out = SSQ + SS; break;
        case 3:  g.A = (const pg8::bf16_t*)(BIG + (size_t)T * 2048); g.Bt = (const pg8::bf16_t*)((const GAS bf16*)(ws + WS_WOUT)); E.mode = EM_RES; E.out = HB; E.res = HA; E.ssq_out = SSQ + 2 * SS; break;
        case 4: case 12:
            g.A = (const pg8::bf16_t*)(layer ? HA : HB); g.Bt = (const pg8::bf16_t*)((const GAS bf16*)(ws + WS_WUP) + (size_t)layer * NUP * 1024); g.N = NUP; g.aperm = 1;
            E.mode = EM_UPCONV; E.out = ACT; E.ldo = DFF; E.ssq_in = SSQ + (layer ? 5 : 2) * SS; E.ssq_out = (GAS float*)(ws + WS_RAW);
            E.cw = INP(17) + (size_t)layer * 3 * NUP; E.bias = INP(18) + (size_t)layer * NUP; E.out_k = (GAS bf16*)(ws + 512 * 1024); break;
        case 6: case 14:
            g.A = (const pg8::bf16_t*)(ACT); g.Bt = (const pg8::bf16_t*)((const GAS bf16*)(ws + WS_WDN) + (size_t)layer * 1024 * DFF); g.K = DFF;
            E.mode = EM_RES; E.out = layer ? HB : HA; E.res = layer ? HA : HB; E.ssq_out = SSQ + (layer ? 6 : 3) * SS; break;
        case 7: case 15:
            g.A = (const pg8::bf16_t*)((const GAS bf16*)(ws + WS_PB) + (size_t)layer * T * 256); g.Bt = (const pg8::bf16_t*)((const GAS bf16*)(ws + WS_WPE) + (size_t)layer * 1024 * 256); g.K = 256; E.mode = EM_PLAIN; E.out = PE; break;
        case 8: case 16: {
            const GAS bf16* hin = layer ? HB : HA; GAS bf16* hout = layer ? HA : HB;
            g.A = (const pg8::bf16_t*)(hin); g.Bt = (const pg8::bf16_t*)((const GAS bf16*)(ws + WS_WG) + (size_t)layer * 1024 * 1024); E.mode = EM_GATE; E.out = hout; E.res = hin; E.pe = PE;
            E.ssq_in = SSQ + (layer ? 6 : 3) * SS; E.ssq_out = SSQ + (layer ? 7 : 4) * SS; E.bias = INP(22) + layer * 1024; break; }
        case 9:  g.A = (const pg8::bf16_t*)(HB); g.Bt = (const pg8::bf16_t*)((const GAS bf16*)(ws + WS_WQKV)); g.N = 1536; E.mode = EM_QKV; E.out = BIG; E.out_k = BIG + (size_t)T * 1024; E.out_v = BIG + (size_t)T * 1280; E.ssq_in = SSQ + 4 * SS; break;
        case 11: g.A = (const pg8::bf16_t*)(BIG + (size_t)T * 1536); g.Bt = (const pg8::bf16_t*)((const GAS bf16*)(ws + WS_WO)); E.mode = EM_RES; E.out = HA; E.res = HB; E.ssq_out = SSQ + 5 * SS; break;
        default: break;
    }
}

__global__ void __launch_bounds__(512, 2) fwd_kernel(Args args) {
    extern __shared__ __attribute__((aligned(16))) unsigned char lds_raw[];
    LAS unsigned char* lds = (LAS unsigned char*)lds_raw;
    cg::grid_group grid = cg::this_grid();
    {
        LAS unsigned long long* PW = (LAS unsigned long long*)(lds + 131072);
        if (threadIdx.x == 0) {
#pragma unroll
            for (int i = 0; i < 23; ++i) PW[i] = (unsigned long long)args.in[i];
            PW[23] = (unsigned long long)args.out; PW[24] = (unsigned long long)args.ws;
            ((LAS unsigned*)(lds + 131072 + 512))[0] = 0u; ((LAS unsigned*)(lds + 131072 + 512))[1] = 0u;
        }
        __syncthreads();
    }
    PTT PT = (PTT)(lds + 131072);
    if (threadIdx.x == 0) {
        unsigned* bar0 = (unsigned*)(args.ws + WS_BAR); const unsigned x0 = xb_xcc_id();
        const unsigned rank0 = xb_add(&bar0[XB_XCNT(x0)], 1u);
        ((LAS unsigned*)(lds + 131072 + 512))[2] = x0; ((LAS unsigned*)(lds + 131072 + 512))[3] = rank0;
    }
    __syncthreads();
    for (int op = args.op_lo; op < args.op_hi; ++op) {
        const int kind = op_kind(op);
#if MK_DIAG
        if (blockIdx.x == 0 && threadIdx.x == 0) { GAS unsigned long long* st = (GAS unsigned long long*)(WSP + 4096); st[64 + 2 * op] = (unsigned long long)clock64(); st[65 + 2 * op] = (unsigned long long)wall_clock64(); }
#endif
        for (int rep = 0; rep < ((MK_REP_MASK >> op) & 1u ? 2 : 1); ++rep) {
        if (rep) __syncthreads();
        if (kind == OP_GEMM) {
            pg8::Gemm g; Epi E; make_gemm(op, PT, g, E); E.skip = (rep > 0 && MK_REP_NOEPI) ? 1 : 0; E.par = (LAS float*)(lds + 131072 + 1024);
            pg8::StaticOrder S; S.init(g.M, g.N, (int)gridDim.x, (int)blockIdx.x);
            pg8::gemm_phase<Epi, pg8::StaticOrder, false>(lds, g, S, E, nullptr);
        } else if (kind == OP_PRO) {
            prologue(PT, lds);
        } else if (kind == OP_SPATIAL) {
            spatial_phase(PT, lds);
        } else if (kind == OP_FIX) {
            const int layer = (op >= 12) ? 1 : 0;
            fix_phase((const GAS float*)(WSP + WS_RAW), (GAS bf16*)(WSP + WS_ACT), INP(17) + (size_t)layer * 3 * NUP, INP(18) + (size_t)layer * NUP);
        } else if (kind == OP_ATTN) {
            attn_phase(PT, lds);
        } else {
            final_phase(PT);
        }
        }
#if MK_DIAG
        if (blockIdx.x == 0 && threadIdx.x == 0) { GAS unsigned long long* st = (GAS unsigned long long*)(WSP + 4096); st[2 * op] = (unsigned long long)clock64() - st[64 + 2 * op]; st[1 + 2 * op] = (unsigned long long)wall_clock64() - st[65 + 2 * op]; }
#endif
        if (op_sync_after(op) && op + 1 < args.op_hi) { if (args.op_lo < 0) grid.sync();   XcdBarrier xbar; xbar.bar = (unsigned*)(WSP + WS_BAR); xbar.st = (volatile LAS unsigned*)(lds + 131072 + 512); xbar.x = (unsigned)__builtin_amdgcn_readfirstlane((int)xbar.st[2]); xcd_barrier(xbar); }
        else __syncthreads();
    }
}
}

#ifndef MK_SINGLE
#define MK_SINGLE 1
#endif
#ifndef MK_MAXOP
#define MK_MAXOP N_OPS
#endif
extern "C" void kernel_launch(void* const* d_in, const int* in_sizes, int n_in, void* d_out, int out_size, void* d_ws, size_t ws_size, hipStream_t stream) {
    using namespace mk;
    static int grid = 0;
    if (grid == 0) {
        if (n_in != 23 || ws_size < WS_END) { fprintf(stderr, "kernel_launch: unexpected n_in %d / ws_size %zu\n", n_in, ws_size); grid = -1; return; }
        int dev = 0, cus = 0, per_cu = 0;
        hipGetDevice(&dev); hipDeviceGetAttribute(&cus, hipDeviceAttributeMultiprocessorCount, dev);
        if (hipFuncSetAttribute((const void*)fwd_kernel, hipFuncAttributeMaxDynamicSharedMemorySize, LDS_BYTES) != hipSuccess) { fprintf(stderr, "kernel_launch: hipFuncSetAttribute failed\n"); grid = -1; return; }
        hipOccupancyMaxActiveBlocksPerMultiprocessor(&per_cu, (const void*)fwd_kernel, 512, LDS_BYTES);
        if (per_cu < 1) { fprintf(stderr, "kernel_launch: occupancy query says %d blocks per CU\n", per_cu); per_cu = 1; }
        (void)hipGetLastError();
        grid = cus;
    }
    if (grid < 0) return;
    Args a{};
    for (int i = 0; i < 23; ++i) a.in[i] = (const float*)d_in[i];
    a.out = (float*)d_out; a.ws = (unsigned char*)d_ws;
#if MK_SINGLE
    if (hipMemsetAsync((char*)d_ws + WS_BAR, 0, WS_BAR_BYTES, stream) != hipSuccess) { fprintf(stderr, "kernel_launch: hipMemsetAsync failed\n"); return; }
    a.op_lo = 0; a.op_hi = MK_MAXOP;
    void* kargs[] = {&a};
    hipError_t e = hipLaunchCooperativeKernel((const void*)fwd_kernel, dim3(grid), dim3(512), kargs, LDS_BYTES, stream);
    if (e != hipSuccess) fprintf(stderr, "cooperative launch failed: %s (grid %d)\n", hipGetErrorString(e), grid);
#else
    int lo = 0;
    for (int op = 0; op < MK_MAXOP; ++op) {
        if (op_sync_after(op) || op == MK_MAXOP - 1) {
            a.op_lo = lo; a.op_hi = op + 1; lo = op + 1;
            hipLaunchKernelGGL(fwd_kernel, dim3(grid), dim3(512), LDS_BYTES, stream, a);
        }
    }
#endif
}
```

```cpp
#include <hip/hip_runtime.h>
#include <hip/hip_cooperative_groups.h>
#include <cstdio>
namespace cg = cooperative_groups;
namespace pg8 {
#define PG8_LAS __attribute__((address_space(3)))
typedef unsigned short bf16_t;
typedef short bf16x8 __attribute__((ext_vector_type(8)));
typedef float f32x4 __attribute__((ext_vector_type(4)));
typedef unsigned u32x4 __attribute__((ext_vector_type(4)));
constexpr int BM = 256, BK = 64, HALF = 128, HTB = HALF * BK * 2  , STAGE_BYTES = 8 * HTB, NXCD = 8, WGM = 8;

__host__ __device__ __forceinline__ int lds_byte(int r, int c) { const int st = (r >> 4) * 2 + (c >> 5), rr = r & 15, cc = c & 31, ob = rr * 64 + cc * 2; return st * 1024 + (ob ^ (((ob >> 9) & 1) << 5)); }
__host__ __device__ __forceinline__ void stage_rc(int b, int& R, int& C) { const int st = b / 1024, sb = b % 1024, swz = sb ^ (((sb >> 9) & 1) << 5); R = (st >> 1) * 16 + swz / 64; C = (st & 1) * 32 + (swz % 64) / 2; }
__host__ __device__ __forceinline__ int perm32(int rho) { const int n = rho >> 4, i = rho & 15; return 8 * (i >> 2) + 4 * n + (i & 3); }

struct Unit { int pm, pn; };
struct Gemm { const bf16_t* A; const bf16_t* Bt; int M, N, K, aperm; };

struct StaticOrder {
    int nM, nN, nwg, G, c;
    __host__ __device__ void init(int M, int N, int G_, int c_) { nM = M / BM; nN = N / BM; nwg = nM * nN; G = G_; c = c_; }
    __host__ __device__ bool next(int i, Unit& u) const {
        const long L = (long)i * G + c; if (L >= nwg) return false;
        int wgid = (int)L; { const int q = nwg / NXCD, r = nwg % NXCD, xcd = wgid % NXCD, off = wgid / NXCD; wgid = (xcd < r ? xcd * (q + 1) : r * (q + 1) + (xcd - r) * q) + off; }
        const int nig = WGM * nN, gid = wgid / nig, fm = gid * WGM, gsz = (nM - fm) < WGM ? (nM - fm) : WGM;
        u.pm = fm + ((wgid % nig) % gsz); u.pn = (wgid % nig) / gsz; return true;
    }
    __device__ __forceinline__ void a_ready(const Unit&) const {}
    __device__ __forceinline__ void done(const Unit&) const {}
};
__device__ __forceinline__ unsigned cvt_pk_bf16(float lo, float hi) { unsigned r; asm volatile("v_cvt_pk_bf16_f32 %0, %1, %2" : "=v"(r) : "v"(lo), "v"(hi)); return r; }
typedef float f32x2 __attribute__((ext_vector_type(2)));
template <class Epi, class Sched, bool STAMP = false>
__device__ __forceinline__ void gemm_phase(PG8_LAS unsigned char* lds, const Gemm g, const Sched& S, const Epi& E, unsigned long long* stamps) {
    int tid_ = threadIdx.x; asm volatile("" : "+v"(tid_));
    const int tid = tid_, wid = __builtin_amdgcn_readfirstlane(tid >> 6), lane = tid & 63, wr = wid >> 2, wc = wid & 3, fr = lane & 15, fq = lane >> 4;
    const int K = g.K, nt = K / BK;
    int nts = 0;
    if (STAMP && stamps && tid < 64) { stamps[tid] = 0ull; if (tid == 62) stamps[62] = (unsigned long long)wall_clock64(); }
#define PG8_STAMP() do { if (STAMP && stamps && wid == 0 && nts < 62) { const unsigned long long _c = (unsigned long long)clock64(); if (lane == 0) stamps[nts] = _c; ++nts; } } while (0)
    PG8_STAMP();
    unsigned voffA[2], voffB[2];
#pragma unroll
    for (int i = 0; i < 2; ++i) { int R, C; stage_rc(tid * 16 + i * 8192, R, C); const int Rb = Epi::PERM ? ((R & ~31) + perm32(R & 31)) : R;
        const int Ra = g.aperm ? (((R >> 6) << 7) + (R & 63)) : R;
        voffA[i] = (unsigned)(Ra * K + C) * 2u; voffB[i] = (unsigned)(Rb * K + C) * 2u; }
    const size_t kstep = (size_t)(BK * 2);
    const size_t hstep = (size_t)HALF * K * 2;
    const size_t hstepA = g.aperm ? hstep / 2 : hstep;
    const size_t tstep = 2 * hstep;
    const unsigned ldsw = (unsigned)wid * 1024u;
    const int aoff = lds_byte(wr * 64 + fr, fq * 8), boff = lds_byte(wc * 32 + fr, fq * 8);
#define PG8_SA(b, h) (((b) * 2 + (h)) * HTB)
#define PG8_SB(b, h) ((4 + (b) * 2 + (h)) * HTB)
#define PG8_STAGE(bufoff, gbase, voff) do { _Pragma("unroll") for (int _i = 0; _i < 2; ++_i) \
        __builtin_amdgcn_global_load_lds((const unsigned*)((const char*)(gbase) + (voff)[_i]), (PG8_LAS unsigned*)(lds + (bufoff) + ldsw + _i * 8192), 16, 0, 0); } while (0)
#define PG8_LDA(dst, b, h) do { _Pragma("unroll") for (int m = 0; m < 4; ++m) _Pragma("unroll") for (int k = 0; k < 2; ++k) dst[m][k] = *(const PG8_LAS bf16x8*)(lds + PG8_SA(b, h) + aoff + m * 2048 + k * 1024); } while (0)
#define PG8_LDB(dst, b, h) do { _Pragma("unroll") for (int n = 0; n < 2; ++n) _Pragma("unroll") for (int k = 0; k < 2; ++k) dst[n][k] = *(const PG8_LAS bf16x8*)(lds + PG8_SB(b, h) + boff + n * 2048 + k * 1024); } while (0)
#define PG8_MMA(ai, bj, At, Bt) do { __builtin_amdgcn_s_setprio(1); _Pragma("unroll") for (int m = 0; m < 4; ++m) _Pragma("unroll") for (int n = 0; n < 2; ++n) _Pragma("unroll") for (int k = 0; k < 2; ++k) \
        acc[ai][bj][m][n] = __builtin_amdgcn_mfma_f32_16x16x32_bf16(Bt[n][k], At[m][k], acc[ai][bj][m][n], 0, 0, 0); __builtin_amdgcn_s_setprio(0); } while (0)
#define PG8_WAIT_V(n) asm volatile("s_waitcnt vmcnt(" #n ")" ::: "memory")
#define PG8_WAIT_L(n) asm volatile("s_waitcnt lgkmcnt(" #n ")" ::: "memory")
#define PG8_BAR __builtin_amdgcn_s_barrier()
#define PG8_SCHED __builtin_amdgcn_sched_barrier(0)
    Unit cur, nxt; int ui = 0;
    if (!S.next(0, cur)) return;
    f32x4 acc[2][2][4][2];
#pragma unroll
    for (int a = 0; a < 2; ++a)
#pragma unroll
        for (int b = 0; b < 2; ++b)
#pragma unroll
            for (int m = 0; m < 4; ++m)
#pragma unroll
                for (int n = 0; n < 2; ++n) acc[a][b][m][n] = (f32x4){0.f, 0.f, 0.f, 0.f};
    bf16x8 At[4][2], B0[2][2], B1[2][2];
    const char* cA = (const char*)g.A + (size_t)cur.pm * tstep; const char* cB = (const char*)g.Bt + (size_t)cur.pn * tstep;
    S.a_ready(cur);
    PG8_STAGE(PG8_SB(0, 0), cB, voffB); PG8_STAGE(PG8_SA(0, 0), cA, voffA); PG8_STAGE(PG8_SB(0, 1), cB + hstep, voffB); PG8_STAGE(PG8_SA(0, 1), cA + hstepA, voffA);
    if (wr == 1) PG8_BAR;
    PG8_WAIT_V(4); PG8_BAR;
    PG8_STAGE(PG8_SB(1, 0), cB + kstep, voffB); PG8_STAGE(PG8_SA(1, 0), cA + kstep, voffA); PG8_STAGE(PG8_SB(1, 1), cB + hstep + kstep, voffB);
    PG8_WAIT_V(6); PG8_BAR;
    PG8_STAMP();
    for (;;) {
        const bool has_next = S.next(ui + 1, nxt);
        const char* nA = has_next ? (const char*)g.A + (size_t)nxt.pm * tstep : cA; const char* nB = has_next ? (const char*)g.Bt + (size_t)nxt.pn * tstep : cB;
        for (int t = 0; t < nt; t += 2) {
            const bool last = (t == nt - 2);
            const char* a1 = cA + (size_t)(t + 1) * kstep;
            const char* a2 = last ? nA : cA + (size_t)(t + 2) * kstep; const char* b2 = last ? nB : cB + (size_t)(t + 2) * kstep;
            const char* a3 = a2 + kstep; const char* b3 = b2 + kstep;
            if (last && has_next) S.a_ready(nxt);
            PG8_LDB(B0, 0, 0); PG8_SCHED; PG8_LDA(At, 0, 0); PG8_STAGE(PG8_SA(1, 1), a1 + hstepA, voffA);
            PG8_WAIT_L(8); PG8_BAR; PG8_WAIT_L(0); PG8_MMA(0, 0, At, B0); PG8_BAR; PG8_SCHED;
            PG8_LDB(B1, 0, 1); PG8_STAGE(PG8_SB(0, 0), b2, voffB);
            PG8_BAR; PG8_WAIT_L(0); PG8_MMA(0, 1, At, B1); PG8_BAR;
            PG8_LDA(At, 0, 1); PG8_STAGE(PG8_SA(0, 0), a2, voffA);
            PG8_BAR; PG8_WAIT_L(0); PG8_MMA(1, 0, At, B0); PG8_BAR; PG8_SCHED;
            PG8_STAGE(PG8_SB(0, 1), b2 + hstep, voffB);
            PG8_WAIT_V(6); PG8_BAR; PG8_MMA(1, 1, At, B1); PG8_BAR;
            PG8_LDB(B0, 1, 0); PG8_SCHED; PG8_LDA(At, 1, 0); PG8_STAGE(PG8_SA(0, 1), a2 + hstepA, voffA);
            PG8_WAIT_L(8); PG8_BAR; PG8_WAIT_L(0); PG8_MMA(0, 0, At, B0); PG8_BAR; PG8_SCHED;
            PG8_LDB(B1, 1, 1); PG8_STAGE(PG8_SB(1, 0), b3, voffB);
            PG8_BAR; PG8_WAIT_L(0); PG8_MMA(0, 1, At, B1); PG8_BAR;
            PG8_LDA(At, 1, 1); PG8_STAGE(PG8_SA(1, 0), a3, voffA);
            PG8_BAR; PG8_WAIT_L(0); PG8_MMA(1, 0, At, B0); PG8_BAR; PG8_SCHED;
            PG8_STAGE(PG8_SB(1, 1), b3 + hstep, voffB);
            PG8_WAIT_V(6); PG8_BAR; PG8_MMA(1, 1, At, B1); PG8_BAR;
        }
        PG8_STAMP();
        if (wr == 0) PG8_BAR;
        if constexpr (!Epi::AFTER_DRAIN) { E(acc, cur, wr, wc, fr, fq); S.done(cur); }
        PG8_STAMP();
        if (!has_next) break;
#pragma unroll
        for (int a = 0; a < 2; ++a)
#pragma unroll
            for (int b = 0; b < 2; ++b)
#pragma unroll
                for (int m = 0; m < 4; ++m)
#pragma unroll
                    for (int n = 0; n < 2; ++n) acc[a][b][m][n] = (f32x4){0.f, 0.f, 0.f, 0.f};
        cur = nxt; cA = nA; cB = nB; ++ui;
        if (wr == 1) PG8_BAR;
    }
    PG8_WAIT_V(0);
    PG8_BAR;
    if constexpr (Epi::AFTER_DRAIN) { E.fused(acc, cur, wr, wc, fr, fq, lds, wid, lane); S.done(cur); }
    PG8_STAMP();
    if (STAMP && stamps && tid == 0) stamps[63] = (unsigned long long)wall_clock64();
#undef PG8_STAMP
#undef PG8_SA
#undef PG8_SB
#undef PG8_STAGE
#undef PG8_LDA
#undef PG8_LDB
#undef PG8_MMA
#undef PG8_WAIT_V
#undef PG8_WAIT_L
#undef PG8_BAR
#undef PG8_SCHED
}
}

namespace mk {
using pg8::bf16x8; using pg8::f32x4; using pg8::Unit;
#define LAS __attribute__((address_space(3)))
#define GAS __attribute__((address_space(1)))
typedef unsigned short bf16;
typedef unsigned v4u __attribute__((ext_vector_type(4)));
typedef unsigned v2u __attribute__((ext_vector_type(2)));
typedef float f32x16 __attribute__((ext_vector_type(16)));
typedef float f32x2_t __attribute__((ext_vector_type(2)));
typedef __bf16 bf16x2_t __attribute__((ext_vector_type(2)));

constexpr int T = 65536, D = 1024, SEQ = 8192, DFF = 2816, NUP = 5632, TH = 32768  ;
constexpr float EPS = 1e-6f;
constexpr size_t MiB = (size_t)1 << 20;
constexpr size_t WS_WIN = 1 * MiB, WS_WOUT = 5 * MiB, WS_WQKV = 7 * MiB, WS_WO = 10 * MiB, WS_WUP = 12 * MiB, WS_WDN = 34 * MiB, WS_WPE = 45 * MiB, WS_WG = 46 * MiB, WS_WS = 50 * MiB;
constexpr size_t WS_SSQ = 56 * MiB;
constexpr size_t WS_PB = 88 * MiB;
constexpr size_t WS_HA = 152 * MiB, WS_HB = 280 * MiB;
constexpr size_t WS_PE = 808 * MiB;
constexpr size_t WS_BIG = 536 * MiB;
constexpr size_t WS_ACT = 408 * MiB;
constexpr size_t WS_RAW = 760 * MiB;
constexpr size_t WS_END = 1024 * MiB;
constexpr int LDS_BYTES = 147456;
constexpr size_t WS_BAR = 64 * 1024, WS_BAR_BYTES = 16 * 1024;

#ifndef MK_DIAG
#define MK_DIAG 0
#endif
#ifndef MK_DIAG_OP
#define MK_DIAG_OP 4
#endif
#ifndef MK_DIAG_MODE
#define MK_DIAG_MODE 0
#endif
#ifndef MK_DIAG_OP2
#define MK_DIAG_OP2 6
#endif
#ifndef MK_REP_MASK
#define MK_REP_MASK 0u
#endif
#ifndef MK_REP_NOEPI
#define MK_REP_NOEPI 0
#endif
struct Args {
    const float* in[23]; float* out; unsigned char* ws; int op_lo, op_hi;
};
typedef LAS const unsigned long long* PTT;
__device__ __forceinline__ unsigned long long ldp(PTT PT, int i) {
    asm volatile("" ::: "memory");
    const unsigned long long v = PT[i];
    const unsigned lo = __builtin_amdgcn_readfirstlane((unsigned)v), hi = __builtin_amdgcn_readfirstlane((unsigned)(v >> 32));
    return ((unsigned long long)hi << 32) | lo;
}
#define INP(i) ((const GAS float*)ldp(PT, (i)))
#define OUTP ((GAS float*)ldp(PT, 23))
#define WSP ((GAS unsigned char*)ldp(PT, 24))

__device__ __forceinline__ int opaque_tid() { int t = threadIdx.x; asm volatile("" : "+v"(t)); return t; }
__device__ __forceinline__ int opaque_bid() { int b = blockIdx.x; asm volatile("" : "+s"(b)); return b; }
__device__ __forceinline__ unsigned f2bf(float f) { unsigned u = __builtin_bit_cast(unsigned, f); return (u + 0x7fffu + ((u >> 16) & 1u)) >> 16; }
__device__ __forceinline__ unsigned pk2(float lo, float hi) { f32x2_t v = {lo, hi}; bf16x2_t b = __builtin_convertvector(v, bf16x2_t); return __builtin_bit_cast(unsigned, b); }
__device__ __forceinline__ float bflo(unsigned w) { return __builtin_bit_cast(float, w << 16); }
__device__ __forceinline__ float bfhi(unsigned w) { return __builtin_bit_cast(float, w & 0xffff0000u); }
__device__ __forceinline__ float bf2f(bf16 b) { return __builtin_bit_cast(float, ((unsigned)b) << 16); }
__device__ __forceinline__ float fast_sigmoid(float x) { return __builtin_amdgcn_rcpf(1.0f + __expf(-x)); }
__device__ __forceinline__ float gelu_tanh(float x) { const float y = x * (1.5957691216f + 0.0713548163f * x * x); return x * __builtin_amdgcn_rcpf(1.0f + __expf(-y)); }
__device__ __forceinline__ float row_rstd(const GAS float* ssq, size_t row) {
    const f32x4 a = *(const GAS f32x4*)(ssq + (row) * 4), b = *(const GAS f32x4*)(ssq + ((size_t)T + row) * 4), c = *(const GAS f32x4*)(ssq + ((size_t)2 * T + row) * 4), d = *(const GAS f32x4*)(ssq + ((size_t)3 * T + row) * 4);
    const float s = ((a[0] + a[1]) + (a[2] + a[3])) + ((b[0] + b[1]) + (b[2] + b[3])) + ((c[0] + c[1]) + (c[2] + c[3])) + ((d[0] + d[1]) + (d[2] + d[3]));
    return rsqrtf(s * (1.0f / 1024.0f) + EPS);
}
__device__ __forceinline__ float wave_sum(float v) {
#pragma unroll
    for (int o = 1; o < 64; o <<= 1) v += __shfl_xor(v, o);
    return v;
}

template <bool APERM> __device__ __forceinline__ void wave_rstd8(const GAS float* ssq, int rowbase, int fq, float (&rs)[8]) {
    f32x4 v[8];
#pragma unroll
    for (int q = 0; q < 8; ++q) { const int row = rowbase + (APERM ? 16 * q : (q >> 2) * 128 + (q & 3) * 16); v[q] = *(const GAS f32x4*)(ssq + ((size_t)fq * T + (size_t)row) * 4); }
#pragma unroll
    for (int q = 0; q < 8; ++q) { float t = (v[q][0] + v[q][1]) + (v[q][2] + v[q][3]); t += __shfl_xor(t, 16); t += __shfl_xor(t, 32); rs[q] = rsqrtf(t * (1.0f / 1024.0f) + EPS); }
}

enum { EM_PLAIN = 0, EM_GELU = 1, EM_RES = 2, EM_SCALE = 3, EM_GATE = 4, EM_QKV = 5, EM_UPCONV = 6 };
__device__ __forceinline__ float dpp_ror1(float x) { return __builtin_bit_cast(float, __builtin_amdgcn_mov_dpp(__builtin_bit_cast(int, x), 0x121, 0xf, 0xf, false)); }
__device__ __forceinline__ float dpp_ror2(float x) { return __builtin_bit_cast(float, __builtin_amdgcn_mov_dpp(__builtin_bit_cast(int, x), 0x122, 0xf, 0xf, false)); }
struct Epi {
    static constexpr bool PERM = true, AFTER_DRAIN = false;
    int mode; GAS bf16* out; int ldo; const GAS bf16* res; const GAS bf16* pe; const GAS float* ssq_in; GAS float* ssq_out; const GAS float* bias; GAS bf16* out_k; GAS bf16* out_v; const GAS float* cw; int skip; LAS float* par;
    __device__ __forceinline__ void upconv(f32x4 (&acc)[2][2][4][2], const Unit& u, int wr, int wc, int fr, int fq) const {
        const int tok0 = u.pm * 256 + wr * 128, jc = u.pn * 128 + wc * 32 + 8 * fq, lane = fq * 16 + fr, wid = wr * 4 + wc;
        const int pa = lane >> 3, pc = 4 * (lane & 7);
        const GAS float* psrc = ((pa < 6) ? cw + (pa % 3) * NUP + ((pa >= 3) ? DFF : 0) : bias + ((pa == 7) ? DFF : 0)) + u.pn * 128 + wc * 32 + pc;
        const f32x4 pv = *(const GAS f32x4*)psrc;
        float rs[8]; wave_rstd8<true>(ssq_in, tok0 + fr, fq, rs);
        LAS float* P = par + wid * 256;
        *(LAS f32x4*)(P + pa * 32 + pc) = pv;
#pragma unroll
        for (int q = 0; q < 8; ++q) { acc[q >> 2][0][q & 3][0] *= rs[q]; acc[q >> 2][0][q & 3][1] *= rs[q]; acc[q >> 2][1][q & 3][0] *= rs[q]; acc[q >> 2][1][q & 3][1] *= rs[q]; }
        GAS float* rawg = ssq_out + (size_t)(2 * u.pm + wr) * 4 * NUP + jc;
        GAS float* dumw = (GAS float*)out_k + (size_t)(blockIdx.x * 8 + wid) * 32;
        { GAS float* pg = (fr < 2) ? rawg + fr * NUP : dumw; GAS float* pu = (fr < 2) ? pg + DFF : dumw + 16;
          *(GAS f32x4*)pg = acc[0][0][0][0]; *(GAS f32x4*)(pg + 4) = acc[0][0][0][1]; *(GAS f32x4*)pu = acc[0][1][0][0]; *(GAS f32x4*)(pu + 4) = acc[0][1][0][1]; }
        { GAS float* pg = (fr >= 14) ? rawg + (fr - 12) * NUP : dumw; GAS float* pu = (fr >= 14) ? pg + DFF : dumw + 16;
          *(GAS f32x4*)pg = acc[1][0][3][0]; *(GAS f32x4*)(pg + 4) = acc[1][0][3][1]; *(GAS f32x4*)pu = acc[1][1][3][0]; *(GAS f32x4*)(pu + 4) = acc[1][1][3][1]; }
        asm volatile("" ::: "memory");
        const bool f1 = fr >= 1, f2 = fr >= 2;
#pragma unroll
        for (int n = 0; n < 2; ++n) {
            unsigned ow[8][2];
#pragma unroll
            for (int kp = 0; kp < 2; ++kp) {
                const LAS float* Pc = P + 8 * fq + 4 * n + 2 * kp;
                const f32x2_t wg0 = *(const LAS f32x2_t*)(Pc), wg1 = *(const LAS f32x2_t*)(Pc + 32), wg2 = *(const LAS f32x2_t*)(Pc + 64);
                const f32x2_t wu0 = *(const LAS f32x2_t*)(Pc + 96), wu1 = *(const LAS f32x2_t*)(Pc + 128), wu2 = *(const LAS f32x2_t*)(Pc + 160);
                const f32x2_t bg = *(const LAS f32x2_t*)(Pc + 192), bu = *(const LAS f32x2_t*)(Pc + 224);
                float r0[8];
#pragma unroll
                for (int kk = 0; kk < 2; ++kk) {
                    const int k = 2 * kp + kk;
                    float g1p = 0.f, g2p = 0.f, u1p = 0.f, u2p = 0.f;
#pragma unroll
                    for (int q = 0; q < 8; ++q) {
                        const float g = acc[q >> 2][0][q & 3][n][k], uu = acc[q >> 2][1][q & 3][n][k];
                        const float g1 = dpp_ror1(g), g2 = dpp_ror2(g), u1 = dpp_ror1(uu), u2 = dpp_ror2(uu);
                        const float pg1 = f1 ? g1 : g1p, pg2 = f2 ? g2 : g2p, pu1 = f1 ? u1 : u1p, pu2 = f2 ? u2 : u2p;
                        const float cg = bg[kk] + wg0[kk] * pg2 + wg1[kk] * pg1 + wg2[kk] * g;
                        const float cu = bu[kk] + wu0[kk] * pu2 + wu1[kk] * pu1 + wu2[kk] * uu;
                        const float res = cg * fast_sigmoid(cg) * cu;
                        if (kk == 0) r0[q] = res; else ow[q][kp] = pk2(r0[q], res);
                        g1p = g1; g2p = g2; u1p = u1; u2p = u2;
                    }
                }
                asm volatile("" ::: "memory");
            }
#pragma unroll
            for (int q = 0; q < 8; ++q) { v2u w; w.x = ow[q][0]; w.y = ow[q][1]; *(GAS v2u*)(out + (size_t)(tok0 + 16 * q + fr) * DFF + jc + 4 * n) = w; }
            asm volatile("" ::: "memory");
        }
    }
    __device__ __forceinline__ void operator()(f32x4 (&acc)[2][2][4][2], const Unit& u, int wr, int wc, int fr, int fq) const {
        if (MK_REP_MASK != 0u && skip) return;
        if (mode == EM_UPCONV) { upconv(acc, u, wr, wc, fr, fq); return; }
        const int row0 = u.pm * 256 + wr * 64 + fr;
        const int colt = u.pn * 256, cw = wc * 32 + 8 * fq;
        GAS bf16* obase = out; int old = ldo, ocol = colt;
        if (mode == EM_QKV) { if (u.pn == 4) { obase = out_k; old = 256; ocol = 0; } else if (u.pn == 5) { obase = out_v; old = 256; ocol = 0; } }
        const bool use_rs = (mode == EM_GELU) | (mode == EM_SCALE) | (mode == EM_GATE) | (mode == EM_QKV);
        const bool do_ssq = (mode == EM_RES) | (mode == EM_GATE) | ((mode == EM_GELU) & (u.pn >= 4));
        const unsigned slotbase = (unsigned)((mode == EM_GELU) ? (u.pn - 4) : u.pn) * (unsigned)T;
        float rsv[8];
        if (use_rs) wave_rstd8<false>(ssq_in, row0, fq, rsv);
        else {
#pragma unroll
            for (int q = 0; q < 8; ++q) rsv[q] = 1.0f; }
        LAS float* Pb = par + (wr * 4 + wc) * 256;
        if (mode == EM_GATE) {
            const int l16 = fq * 16 + fr;
            if (l16 < 16) *(LAS f32x4*)(Pb + (l16 >> 3) * 32 + 4 * (l16 & 7)) = *(const GAS f32x4*)(bias + colt + (l16 >> 3) * 128 + wc * 32 + 4 * (l16 & 7));
        }
#pragma unroll
        for (int aq = 0; aq < 4; ++aq) {
            const int ai = aq >> 1, m0 = (aq & 1) * 2;
            v4u rr[2][2], ee[2][2];
            if ((mode == EM_RES) | (mode == EM_GATE)) {
#pragma unroll
                for (int mm = 0; mm < 2; ++mm)
#pragma unroll
                    for (int bj = 0; bj < 2; ++bj) rr[mm][bj] = *(const GAS v4u*)(res + ((unsigned)(row0 + ai * 128 + (m0 + mm) * 16) * 1024u + (unsigned)(colt + bj * 128 + cw)));
            }
            if (mode == EM_GATE) {
#pragma unroll
                for (int mm = 0; mm < 2; ++mm)
#pragma unroll
                    for (int bj = 0; bj < 2; ++bj) ee[mm][bj] = *(const GAS v4u*)(pe + ((unsigned)(row0 + ai * 128 + (m0 + mm) * 16) * 1024u + (unsigned)(colt + bj * 128 + cw)));
            }
            __builtin_amdgcn_sched_barrier(0);
#pragma unroll
            for (int mm = 0; mm < 2; ++mm) {
                const int m = m0 + mm;
                const unsigned row = (unsigned)(row0 + ai * 128 + m * 16);
                const float rs = rsv[ai * 4 + m];
                float sq = 0.f;
#pragma unroll
                for (int bj = 0; bj < 2; ++bj) {
                    f32x4 v0 = acc[ai][bj][m][0] * rs, v1 = acc[ai][bj][m][1] * rs;
                    if (mode == EM_GELU) {
#pragma unroll
                        for (int j = 0; j < 4; ++j) { v0[j] = gelu_tanh(v0[j]); v1[j] = gelu_tanh(v1[j]); }
                    } else if (mode == EM_RES) {
                        const v4u r = rr[mm][bj];
                        v0[0] += bflo(r.x); v0[1] += bfhi(r.x); v0[2] += bflo(r.y); v0[3] += bfhi(r.y);
                        v1[0] += bflo(r.z); v1[1] += bfhi(r.z); v1[2] += bflo(r.w); v1[3] += bfhi(r.w);
                    } else if (mode == EM_GATE) {
                        const v4u r = rr[mm][bj], e = ee[mm][bj];
                        const f32x4 b0 = *(const LAS f32x4*)(Pb + bj * 32 + 8 * fq), b1 = *(const LAS f32x4*)(Pb + bj * 32 + 8 * fq + 4);
                        v0[0] = bflo(r.x) + bflo(e.x) * fast_sigmoid(v0[0] + b0[0]); v0[1] = bfhi(r.x) + bfhi(e.x) * fast_sigmoid(v0[1] + b0[1]);
                        v0[2] = bflo(r.y) + bflo(e.y) * fast_sigmoid(v0[2] + b0[2]); v0[3] = bfhi(r.y) + bfhi(e.y) * fast_sigmoid(v0[3] + b0[3]);
                        v1[0] = bflo(r.z) + bflo(e.z) * fast_sigmoid(v1[0] + b1[0]); v1[1] = bfhi(r.z) + bfhi(e.z) * fast_sigmoid(v1[1] + b1[1]);
                        v1[2] = bflo(r.w) + bflo(e.w) * fast_sigmoid(v1[2] + b1[2]); v1[3] = bfhi(r.w) + bfhi(e.w) * fast_sigmoid(v1[3] + b1[3]);
                    }
                    sq += (v0[0] * v0[0] + v0[1] * v0[1]) + (v0[2] * v0[2] + v0[3] * v0[3]) + (v1[0] * v1[0] + v1[1] * v1[1]) + (v1[2] * v1[2] + v1[3] * v1[3]);
                    v4u w; w.x = pk2(v0[0], v0[1]); w.y = pk2(v0[2], v0[3]); w.z = pk2(v1[0], v1[1]); w.w = pk2(v1[2], v1[3]);
                    *(GAS v4u*)(obase + (row * (unsigned)old + (unsigned)(ocol + bj * 128 + cw))) = w;
                }
                if (do_ssq) {
                    sq += __shfl_xor(sq, 16); sq += __shfl_xor(sq, 32);
                    if (fq == 0) ssq_out[(slotbase + row) * 4u + (unsigned)wc] = sq;
                }
            }
            __builtin_amdgcn_sched_barrier(0);
        }
    }
};

__device__ __forceinline__ void transpose_item(const GAS float* W, int K, int N, GAS bf16* WT, int row_off, const GAS float* gain, LAS float* scr, int item, int lane, bool upperm) {
    const int nblk = N / 32, kb = item / nblk, nb = item % nblk, k0 = 64 * kb, n0 = 32 * nb;
    int r0 = row_off + n0;
    if (upperm) { const int bj = (n0 >= DFF) ? 1 : 0, ci = n0 - DFF * bj; r0 = 256 * (ci >> 7) + 128 * bj + (ci & 127); }
#pragma unroll 16
    for (int i = 0; i < 32; ++i) { const int kk = 2 * i + (lane >> 5); const float gsc = gain ? gain[k0 + kk] : 1.0f; scr[kk * 33 + (lane & 31)] = W[(size_t)(k0 + kk) * N + n0 + (lane & 31)] * gsc; }
    asm volatile("s_waitcnt lgkmcnt(0)" ::: "memory");
    const int c = lane & 7;
#pragma unroll
    for (int j = 0; j < 4; ++j) { const int n = (lane >> 3) + 8 * j; const LAS float* s = scr + (8 * c) * 33 + n;
        v4u o; o.x = pk2(s[0 * 33], s[1 * 33]); o.y = pk2(s[2 * 33], s[3 * 33]); o.z = pk2(s[4 * 33], s[5 * 33]); o.w = pk2(s[6 * 33], s[7 * 33]);
        *(GAS v4u*)(WT + (size_t)(r0 + n) * K + k0 + 8 * c) = o; }
    asm volatile("s_waitcnt lgkmcnt(0)" ::: "memory");
}

__device__ __forceinline__ void prologue(PTT PT, LAS unsigned char* lds) {
    const int tid = opaque_tid(), bid = opaque_bid(), lane = tid & 63, wave = tid >> 6;
    const int gw = bid * 8 + wave, NGW = gridDim.x * 8;
    LAS float* scr = (LAS float*)(lds + wave * 16384);
    GAS unsigned char* ws = WSP;
    if (wave & 1) {
        const int tw = bid * 4 + (wave >> 1), NTW = gridDim.x * 4;
        for (int gi = tw; gi < 12544; gi += NTW) {
            const GAS float* W; int K, N, ro = 0, it = gi, mi; GAS bf16* WT; const GAS float* gain = nullptr;
            if (gi < 1024) { mi = 0; W = INP(7); K = 1024; N = 2048; WT = (GAS bf16*)(ws + WS_WIN); gain = INP(2); }
            else if (gi < 1536) { mi = 1; it = gi - 1024; W = INP(11); K = 1024; N = 1024; WT = (GAS bf16*)(ws + WS_WOUT); }
            else if (gi < 2048) { mi = 2; it = gi - 1536; W = INP(13); K = 1024; N = 1024; WT = (GAS bf16*)(ws + WS_WQKV); gain = INP(2) + 1024; }
            else if (gi < 2304) { mi = 3; it = gi - 2048; W = INP(12); K = 1024; N = 512; WT = (GAS bf16*)(ws + WS_WQKV); ro = 1024; gain = INP(5); }
            else if (gi < 2816) { mi = 4; it = gi - 2304; W = INP(15); K = 1024; N = 1024; WT = (GAS bf16*)(ws + WS_WO); }
            else if (gi < 5632) { mi = 5; it = gi - 2816; W = INP(16); K = 1024; N = NUP; WT = (GAS bf16*)(ws + WS_WUP); gain = INP(3); }
            else if (gi < 8448) { mi = 6; it = gi - 5632; W = INP(16) + (size_t)1024 * NUP; K = 1024; N = NUP; WT = (GAS bf16*)(ws + WS_WUP) + (size_t)NUP * 1024; gain = INP(3) + 1024; }
            else if (gi < 9856) { mi = 7; it = gi - 8448; W = INP(19); K = DFF; N = 1024; WT = (GAS bf16*)(ws + WS_WDN); }
            else if (gi < 11264) { mi = 8; it = gi - 9856; W = INP(19) + (size_t)DFF * 1024; K = DFF; N = 1024; WT = (GAS bf16*)(ws + WS_WDN) + (size_t)1024 * DFF; }
            else if (gi < 11392) { mi = 9; it = gi - 11264; W = INP(20); K = 256; N = 1024; WT = (GAS bf16*)(ws + WS_WPE); }
            else if (gi < 11520) { mi = 10; it = gi - 11392; W = INP(20) + (size_t)256 * 1024; K = 256; N = 1024; WT = (GAS bf16*)(ws + WS_WPE) + (size_t)1024 * 256; }
            else if (gi < 12032) { mi = 11; it = gi - 11520; W = INP(21); K = 1024; N = 1024; WT = (GAS bf16*)(ws + WS_WG); gain = INP(4); }
            else { mi = 12; it = gi - 12032; W = INP(21) + (size_t)1024 * 1024; K = 1024; N = 1024; WT = (GAS bf16*)(ws + WS_WG) + (size_t)1024 * 1024; gain = INP(4) + 1024; }
            transpose_item(W, K, N, WT, ro, gain, scr, it, lane, mi == 5 || mi == 6);
        }
    }
    {
        const GAS float* w = INP(9); GAS bf16* o = (GAS bf16*)(ws + WS_WS);
        for (int i = bid * 512 + tid; i < 8 * 128 * 128; i += gridDim.x * 512) { const int s = i & 127, t = (i >> 7) & 127; o[i] = (bf16)f2bf(s <= t ? w[i] : 0.0f); }
    }
    {
        const GAS float* x = INP(0); GAS bf16* xb = (GAS bf16*)(ws + WS_HA); GAS float* ssq0 = (GAS float*)(ws + WS_SSQ);
        if (!(wave & 1))
#pragma unroll 8
        for (int r = bid * 4 + (wave >> 1); r < T; r += gridDim.x * 4) {
            const GAS f32x4* xr = (const GAS f32x4*)(x + (size_t)r * D) + lane; float s = 0.f;
            GAS unsigned long long* o8 = (GAS unsigned long long*)(xb + (size_t)r * D) + lane;
#pragma unroll
            for (int j = 0; j < 4; ++j) { const f32x4 v = xr[64 * j]; s += (v[0] * v[0] + v[1] * v[1]) + (v[2] * v[2] + v[3] * v[3]);
                o8[64 * j] = (unsigned long long)pk2(v[0], v[1]) | ((unsigned long long)pk2(v[2], v[3]) << 32); }
            s = wave_sum(s);
            if (lane < 16) ssq0[((size_t)(lane >> 2) * T + (size_t)r) * 4 + (lane & 3)] = (lane == 0) ? s : 0.f;
        }
    }
    {
        const GAS f32x4* p4 = (const GAS f32x4*)INP(1); GAS unsigned long long* o8 = (GAS unsigned long long*)(ws + WS_PB);
        const size_t n4 = (size_t)2 * T * 256 / 4;
#pragma unroll 8
        for (size_t i = (size_t)bid * 512 + tid; i < n4; i += (size_t)gridDim.x * 512) { const f32x4 v = p4[i]; o8[i] = (unsigned long long)pk2(v[0], v[1]) | ((unsigned long long)pk2(v[2], v[3]) << 32); }
    }
}

__device__ __forceinline__ void spatial_phase(PTT PT, LAS unsigned char* lds) {
    const int tid = opaque_tid(), bid = opaque_bid(), lane = tid & 63, wave = __builtin_amdgcn_readfirstlane(tid >> 6), r = lane & 31, hh = lane >> 5;
    GAS unsigned char* ws = WSP;
    const GAS bf16* z = (const GAS bf16*)(ws + WS_BIG); GAS bf16* us = (GAS bf16*)(ws + WS_BIG + 256 * MiB);
    const GAS float* ssq1 = (const GAS float*)(ws + WS_SSQ + 1 * 4 * MiB);
    const GAS bf16* Wsb = (const GAS bf16*)(ws + WS_WS);
    const GAS float* gv = INP(8); const GAS float* bs = INP(10);
    LAS unsigned* vT32 = (LAS unsigned*)lds;
    LAS unsigned char* vTb = lds;
    const int tt = wave >> 1, dd0 = (wave & 1) * 2, p = tid & 63;
    int hcur = -1; bf16x8 af[8]; float biasv[16]; f32x4 gg[2][2];
    v4u nva[2], nvb[2]; float nrsa = 0.f, nrsb = 0.f;
#define SP_FETCH(UU) do { const int h_ = (UU) & 7, c_ = (UU) >> 3; const size_t ra_ = (size_t)c_ * 128 + 2 * p, rb_ = ra_ + 1; \
        nrsa = row_rstd(ssq1, ra_); nrsb = row_rstd(ssq1, rb_); \
        _Pragma("unroll") for (int it = 0; it < 2; ++it) { const int cc = (tid >> 6) + 8 * it; \
            nva[it] = *(const GAS v4u*)(z + ra_ * 2048 + 1024 + h_ * 128 + cc * 8); nvb[it] = *(const GAS v4u*)(z + rb_ * 2048 + 1024 + h_ * 128 + cc * 8); } } while (0)
    if (bid < 4096) SP_FETCH(bid);
    for (int u = bid; u < 4096; u += gridDim.x) {
        const int h = u & 7, c = u >> 3; const size_t tok0 = (size_t)c * 128;
        if (h != hcur) {
            hcur = h;
            const GAS bf16* wrow = Wsb + ((size_t)(h * 128 + 32 * tt + r)) * 128 + 8 * hh;
#pragma unroll
            for (int ks = 0; ks < 8; ++ks) af[ks] = *(const GAS bf16x8*)(wrow + 16 * ks);
#pragma unroll
            for (int reg = 0; reg < 16; ++reg) biasv[reg] = bs[h * 128 + 32 * tt + (reg & 3) + 8 * (reg >> 2) + 4 * hh];
#pragma unroll
            for (int it = 0; it < 2; ++it) { const int cc = (tid >> 6) + 8 * it; gg[it][0] = *(const GAS f32x4*)(gv + h * 128 + cc * 8); gg[it][1] = *(const GAS f32x4*)(gv + h * 128 + cc * 8 + 4); }
        }
        __syncthreads();
#pragma unroll
        for (int it = 0; it < 2; ++it) {
            const int cc = (tid >> 6) + 8 * it;
            const v4u va = nva[it], vb = nvb[it]; const f32x4 g0 = gg[it][0], g1 = gg[it][1]; const float rsa = nrsa, rsb = nrsb;
            LAS unsigned* dst = vT32 + (cc * 8) * 68 + p;
            dst[0 * 68] = pk2(bflo(va.x) * rsa * g0[0], bflo(vb.x) * rsb * g0[0]);
            dst[1 * 68] = pk2(bfhi(va.x) * rsa * g0[1], bfhi(vb.x) * rsb * g0[1]);
            dst[2 * 68] = pk2(bflo(va.y) * rsa * g0[2], bflo(vb.y) * rsb * g0[2]);
            dst[3 * 68] = pk2(bfhi(va.y) * rsa * g0[3], bfhi(vb.y) * rsb * g0[3]);
            dst[4 * 68] = pk2(bflo(va.z) * rsa * g1[0], bflo(vb.z) * rsb * g1[0]);
            dst[5 * 68] = pk2(bfhi(va.z) * rsa * g1[1], bfhi(vb.z) * rsb * g1[1]);
            dst[6 * 68] = pk2(bflo(va.w) * rsa * g1[2], bflo(vb.w) * rsb * g1[2]);
            dst[7 * 68] = pk2(bfhi(va.w) * rsa * g1[3], bfhi(vb.w) * rsb * g1[3]);
        }
        __syncthreads();
        if (u + (int)gridDim.x < 4096) SP_FETCH(u + (int)gridDim.x);
        bf16 uv0[16], uv1[16];
#pragma unroll
        for (int reg = 0; reg < 16; ++reg) { const size_t tok = tok0 + 32 * tt + (reg & 3) + 8 * (reg >> 2) + 4 * hh; const int ch = h * 128 + 32 * dd0 + r;
            uv0[reg] = z[tok * 2048 + ch]; uv1[reg] = z[tok * 2048 + ch + 32]; }
        f32x16 acc0, acc1;
#pragma unroll
        for (int i = 0; i < 16; ++i) { acc0[i] = 0.f; acc1[i] = 0.f; }
        const LAS unsigned char* b0p = vTb + (32 * dd0 + r) * 272 + 16 * hh, * b1p = b0p + 32 * 272;
        const int nks = 2 * tt + 2;
#pragma unroll
        for (int ks = 0; ks < 8; ++ks) {
            if (ks < nks) {
                const bf16x8 bf0 = *(const LAS bf16x8*)(b0p + 32 * ks), bf1 = *(const LAS bf16x8*)(b1p + 32 * ks);
                acc0 = __builtin_amdgcn_mfma_f32_32x32x16_bf16(af[ks], bf0, acc0, 0, 0, 0);
                acc1 = __builtin_amdgcn_mfma_f32_32x32x16_bf16(af[ks], bf1, acc1, 0, 0, 0);
            }
        }
#pragma unroll
        for (int reg = 0; reg < 16; ++reg) {
            const int t = 32 * tt + (reg & 3) + 8 * (reg >> 2) + 4 * hh;
            const size_t tok = tok0 + t; const int ch = h * 128 + 32 * dd0 + r;
            const float u0 = bf2f(uv0[reg]), u1 = bf2f(uv1[reg]);
            us[tok * 1024 + ch] = (bf16)f2bf(u0 * (acc0[reg] + biasv[reg]));
            us[tok * 1024 + ch + 32] = (bf16)f2bf(u1 * (acc1[reg] + biasv[reg]));
        }
    }
#undef SP_FETCH
}

__device__ __forceinline__ void fix_phase(const GAS float* raw, GAS bf16* act, const GAS float* cw, const GAS float* cb) {
    constexpr int NC4 = DFF / 4;
    const int nitems = 512 * NC4;
    for (int it = opaque_bid() * 512 + opaque_tid(); it < nitems; it += gridDim.x * 512) {
        const int grp = it / NC4, c4 = (it % NC4) * 4;
        const f32x4 wg0 = *(const GAS f32x4*)(cw + c4), wg1 = *(const GAS f32x4*)(cw + NUP + c4), wg2 = *(const GAS f32x4*)(cw + 2 * NUP + c4);
        const f32x4 wu0 = *(const GAS f32x4*)(cw + DFF + c4), wu1 = *(const GAS f32x4*)(cw + NUP + DFF + c4), wu2 = *(const GAS f32x4*)(cw + 2 * NUP + DFF + c4);
        const f32x4 bg = *(const GAS f32x4*)(cb + c4), bu = *(const GAS f32x4*)(cb + DFF + c4);
        const GAS float* rc = raw + (size_t)grp * 4 * NUP + c4;
        const f32x4 g0 = *(const GAS f32x4*)(rc), u0 = *(const GAS f32x4*)(rc + DFF), g1 = *(const GAS f32x4*)(rc + NUP), u1 = *(const GAS f32x4*)(rc + NUP + DFF);
        f32x4 gm2 = {0.f, 0.f, 0.f, 0.f}, gm1 = gm2, um2 = gm2, um1 = gm2;
        if ((grp & 63) != 0) { const GAS float* rp = rc - 4 * NUP; gm2 = *(const GAS f32x4*)(rp + 2 * NUP); um2 = *(const GAS f32x4*)(rp + 2 * NUP + DFF); gm1 = *(const GAS f32x4*)(rp + 3 * NUP); um1 = *(const GAS f32x4*)(rp + 3 * NUP + DFF); }
        float a0[4], a1[4];
#pragma unroll
        for (int k = 0; k < 4; ++k) {
            const float cg0 = bg[k] + wg0[k] * gm2[k] + wg1[k] * gm1[k] + wg2[k] * g0[k], cu0 = bu[k] + wu0[k] * um2[k] + wu1[k] * um1[k] + wu2[k] * u0[k];
            const float cg1 = bg[k] + wg0[k] * gm1[k] + wg1[k] * g0[k] + wg2[k] * g1[k], cu1 = bu[k] + wu0[k] * um1[k] + wu1[k] * u0[k] + wu2[k] * u1[k];
            a0[k] = cg0 * fast_sigmoid(cg0) * cu0; a1[k] = cg1 * fast_sigmoid(cg1) * cu1;
        }
        v2u w0, w1; w0.x = pk2(a0[0], a0[1]); w0.y = pk2(a0[2], a0[3]); w1.x = pk2(a1[0], a1[1]); w1.y = pk2(a1[2], a1[3]);
        GAS bf16* ar = act + (size_t)grp * 128 * DFF + c4;
        *(GAS v2u*)ar = w0; *(GAS v2u*)(ar + DFF) = w1;
    }
}

__device__ __forceinline__ void attn_phase(PTT PT, LAS unsigned char* lds) {
    const int tid = opaque_tid(), bid = opaque_bid(), lane = tid & 63, wave = __builtin_amdgcn_readfirstlane(tid >> 6), r = lane & 31, hh = lane >> 5;
    GAS unsigned char* ws = WSP;
    const GAS bf16* qb = (const GAS bf16*)(ws + WS_BIG); const GAS bf16* kb = (const GAS bf16*)(ws + WS_BIG + 128 * MiB); const GAS bf16* vb = (const GAS bf16*)(ws + WS_BIG + 160 * MiB);
    GAS bf16* ao = (GAS bf16*)(ws + WS_BIG + 192 * MiB);
    const GAS float* sinks = INP(14);
    LAS unsigned char* Ks = lds;
    LAS unsigned* Vt32 = (LAS unsigned*)(lds + 36864);
    LAS unsigned char* Vtb = lds + 36864;
    v4u kreg[4], vreg[2][2]; bf16x8 qn[2][4];
#define ATTN_FETCH(UU) do { const int kvh_ = (UU) & 3, nb_ = ((UU) >> 2) & 63, b_ = (UU) >> 8; const long t0_ = (long)b_ * SEQ + (long)nb_ * 128; \
        _Pragma("unroll") for (int it = 0; it < 4; ++it) { const int idx = tid + 512 * it, row = idx >> 3, c = idx & 7; const long tok = t0_ - 128 + row; \
            v4u val = {0u, 0u, 0u, 0u}; if (nb_ > 0 || row >= 128) val = *(const GAS v4u*)(kb + tok * 256 + kvh_ * 64 + c * 8); kreg[it] = val; } \
        _Pragma("unroll") for (int it = 0; it < 2; ++it) { const int p = tid & 127, c = (tid >> 7) + 4 * it; const long tok = t0_ - 128 + 2 * p; \
            v4u va = {0u, 0u, 0u, 0u}, vbv = va; if (nb_ > 0 || p >= 64) { va = *(const GAS v4u*)(vb + tok * 256 + kvh_ * 64 + c * 8); vbv = *(const GAS v4u*)(vb + (tok + 1) * 256 + kvh_ * 64 + c * 8); } \
            vreg[it][0] = va; vreg[it][1] = vbv; } \
        _Pragma("unroll") for (int i_ = 0; i_ < 2; ++i_) { const int wu_ = wave + 8 * i_; const GAS bf16* qrow_ = qb + (size_t)(t0_ + 32 * (wu_ >> 2) + r) * 1024 + (kvh_ * 4 + (wu_ & 3)) * 64 + 8 * hh; \
            _Pragma("unroll") for (int ks = 0; ks < 4; ++ks) qn[i_][ks] = *(const GAS bf16x8*)(qrow_ + 16 * ks); } } while (0)
    if (bid < 2048) ATTN_FETCH(bid);
    for (int u = bid; u < 2048; u += gridDim.x) {
        const int kvh = u & 3, nb = (u >> 2) & 63, b = u >> 8;
        const long t0 = (long)b * SEQ + (long)nb * 128;
        __syncthreads();
#pragma unroll
        for (int it = 0; it < 4; ++it) { const int idx = tid + 512 * it, row = idx >> 3, c = idx & 7; *(LAS v4u*)(Ks + row * 144 + c * 16) = kreg[it]; }
#pragma unroll
        for (int it = 0; it < 2; ++it) {
            const int p = tid & 127, c = (tid >> 7) + 4 * it; const v4u va = vreg[it][0], vbv = vreg[it][1];
            LAS unsigned* dst = Vt32 + (c * 8) * 130 + p;
            dst[0 * 130] = (va.x & 0xffffu) | (vbv.x << 16); dst[1 * 130] = (va.x >> 16) | (vbv.x & 0xffff0000u);
            dst[2 * 130] = (va.y & 0xffffu) | (vbv.y << 16); dst[3 * 130] = (va.y >> 16) | (vbv.y & 0xffff0000u);
            dst[4 * 130] = (va.z & 0xffffu) | (vbv.z << 16); dst[5 * 130] = (va.z >> 16) | (vbv.z & 0xffff0000u);
            dst[6 * 130] = (va.w & 0xffffu) | (vbv.w << 16); dst[7 * 130] = (va.w >> 16) | (vbv.w & 0xffff0000u);
        }
        __syncthreads();
        bf16x8 qc[2][4];
#pragma unroll
        for (int i = 0; i < 2; ++i)
#pragma unroll
            for (int ks = 0; ks < 4; ++ks) qc[i][ks] = qn[i][ks];
        if (u + (int)gridDim.x < 2048) ATTN_FETCH(u + (int)gridDim.x);
#pragma unroll
        for (int i = 0; i < 2; ++i) {
            const int wu = wave + 8 * i, g = wu & 3, qt = wu >> 2, head = kvh * 4 + g, i0 = 32 * qt;
            bf16x8 qf[4];
#pragma unroll
            for (int ks = 0; ks < 4; ++ks) qf[ks] = qc[i][ks];
            const float slope = exp2f(-0.5f * (float)(head + 1)), sink = sinks[head];
            const int kk_lo = (nb > 0) ? 0 : ((qt < 4) ? 4 - qt : 0);
            float mx = sink;
#pragma unroll 1
            for (int kk = kk_lo; kk < 5; ++kk) {
                f32x16 sc;
#pragma unroll
                for (int e = 0; e < 16; ++e) sc[e] = 0.f;
                const LAS unsigned char* kp = Ks + (32 * (qt + kk) + r) * 144 + 16 * hh;
#pragma unroll
                for (int ks = 0; ks < 4; ++ks) { const bf16x8 kf = *(const LAS bf16x8*)(kp + 32 * ks); sc = __builtin_amdgcn_mfma_f32_32x32x16_bf16(kf, qf[ks], sc, 0, 0, 0); }
                const int rdk = r + 128 - 32 * kk - 4 * hh;
#pragma unroll
                for (int e = 0; e < 16; ++e) {
                    const int dist = rdk - ((e & 3) + 8 * (e >> 2));
                    const float sv = fmaf(-slope, (float)dist, sc[e] * 0.125f);
                    mx = ((unsigned)dist < 128u) ? fmaxf(mx, sv) : mx;
                }
            }
            mx = fmaxf(mx, __shfl_xor(mx, 32));
            float sum = 0.f;
            f32x16 o0, o1;
#pragma unroll
            for (int e = 0; e < 16; ++e) { o0[e] = 0.f; o1[e] = 0.f; }
#pragma unroll 1
            for (int kk = kk_lo; kk < 5; ++kk) {
                f32x16 sc;
#pragma unroll
                for (int e = 0; e < 16; ++e) sc[e] = 0.f;
                const LAS unsigned char* kp = Ks + (32 * (qt + kk) + r) * 144 + 16 * hh;
#pragma unroll
                for (int ks = 0; ks < 4; ++ks) { const bf16x8 kf = *(const LAS bf16x8*)(kp + 32 * ks); sc = __builtin_amdgcn_mfma_f32_32x32x16_bf16(kf, qf[ks], sc, 0, 0, 0); }
                const int rdk = r + 128 - 32 * kk - 4 * hh;
#pragma unroll
                for (int e = 0; e < 16; ++e) {
                    const int dist = rdk - ((e & 3) + 8 * (e >> 2));
                    const float sv = fmaf(-slope, (float)dist, sc[e] * 0.125f);
                    const float ev = ((unsigned)dist < 128u) ? __expf(sv - mx) : 0.f;
                    sc[e] = ev; sum += ev;
                }
#pragma unroll
                for (int s2 = 0; s2 < 2; ++s2) {
                    v4u pw;
                    pw.x = pk2(sc[8 * s2 + 0], sc[8 * s2 + 1]); pw.y = pk2(sc[8 * s2 + 2], sc[8 * s2 + 3]);
                    pw.z = pk2(sc[8 * s2 + 4], sc[8 * s2 + 5]); pw.w = pk2(sc[8 * s2 + 6], sc[8 * s2 + 7]);
                    const bf16x8 pa = __builtin_bit_cast(bf16x8, pw);
                    const int key0 = 32 * (qt + kk) + 16 * s2 + 4 * hh;
                    const LAS unsigned char* v0p = Vtb + r * 520 + key0 * 2, * v1p = v0p + 32 * 520;
                    const v2u x0 = *(const LAS v2u*)(v0p), x1 = *(const LAS v2u*)(v0p + 16), y0 = *(const LAS v2u*)(v1p), y1 = *(const LAS v2u*)(v1p + 16);
                    v4u vw0, vw1; vw0.x = x0.x; vw0.y = x0.y; vw0.z = x1.x; vw0.w = x1.y; vw1.x = y0.x; vw1.y = y0.y; vw1.z = y1.x; vw1.w = y1.y;
                    o0 = __builtin_amdgcn_mfma_f32_32x32x16_bf16(pa, __builtin_bit_cast(bf16x8, vw0), o0, 0, 0, 0);
                    o1 = __builtin_amdgcn_mfma_f32_32x32x16_bf16(pa, __builtin_bit_cast(bf16x8, vw1), o1, 0, 0, 0);
                }
            }
            sum += __shfl_xor(sum, 32);
            const float inv = 1.0f / (sum + __expf(sink - mx));
#pragma unroll
            for (int e = 0; e < 16; ++e) {
                const int qr = (e & 3) + 8 * (e >> 2) + 4 * hh;
                const float ie = __shfl(inv, qr);
                GAS bf16* orow = ao + (size_t)(t0 + i0 + qr) * 1024 + head * 64 + r;
                orow[0] = (bf16)f2bf(o0[e] * ie); orow[32] = (bf16)f2bf(o1[e] * ie);
            }
        }
    }
#undef ATTN_FETCH
}

__device__ __forceinline__ void final_phase(PTT PT) {
    const int tid = opaque_tid(), lane = tid & 63, wave = tid >> 6;
    const int gw = opaque_bid() * 8 + wave, NGW = gridDim.x * 8;
    const GAS bf16* h = (const GAS bf16*)(WSP + WS_HA); const GAS float* ssq = (const GAS float*)(WSP + WS_SSQ + 7 * 4 * MiB); const GAS float* gf = INP(6);
    f32x4 g[4];
#pragma unroll
    for (int j = 0; j < 2; ++j) { g[2 * j] = *(const GAS f32x4*)(gf + 512 * j + lane * 8); g[2 * j + 1] = *(const GAS f32x4*)(gf + 512 * j + lane * 8 + 4); }
#if MK_DIAG
    float dA = 0.f; unsigned dM = 0;
    {
        const GAS unsigned long long* st = (const GAS unsigned long long*)(WSP + 4096);
        const float cyc = (float)st[2 * MK_DIAG_OP], us = (float)st[2 * MK_DIAG_OP + 1] * 0.01f, us2 = (float)st[2 * MK_DIAG_OP2 + 1] * 0.01f;
        if (MK_DIAG_MODE == 0) { dA = cyc / us * (1.0f / 100.0f); dM = (unsigned)(us * 1000.0f); }
        else { dA = us2 * (1.0f / 10.0f); dM = (unsigned)(us * 1000.0f); }
    }
#endif
#pragma unroll 8
    for (int r = gw; r < T; r += NGW) {
        const float rs = row_rstd(ssq, (size_t)r);
#pragma unroll
        for (int j = 0; j < 2; ++j) {
            const v4u w = *(const GAS v4u*)(h + (size_t)r * D + 512 * j + lane * 8);
            f32x4 o0, o1;
            o0[0] = bflo(w.x) * rs * g[2 * j][0]; o0[1] = bfhi(w.x) * rs * g[2 * j][1]; o0[2] = bflo(w.y) * rs * g[2 * j][2]; o0[3] = bfhi(w.y) * rs * g[2 * j][3];
            o1[0] = bflo(w.z) * rs * g[2 * j + 1][0]; o1[1] = bfhi(w.z) * rs * g[2 * j + 1][1]; o1[2] = bflo(w.w) * rs * g[2 * j + 1][2]; o1[3] = bfhi(w.w) * rs * g[2 * j + 1][3];
#if MK_DIAG
            { const unsigned e0 = (unsigned)r * 1024u + 512u * j + lane * 8u;
#pragma unroll
              for (int k = 0; k < 4; ++k) { if (e0 + k < dM) o0[k] += 1.0f; if (e0 + 4 + k < dM) o1[k] += 1.0f; }
              if (e0 == 0) o0[0] += dA; }
#endif
            GAS float* op = OUTP + (size_t)r * D + 512 * j + lane * 8;
            *(GAS f32x4*)op = o0; *(GAS f32x4*)(op + 4) = o1;
        }
    }
}

#define XB_TMO      128
#define XB_XCNT(j)  (256  + 64 * (j))
#define XB_XSUB(j)  (1280 + 64 * (j))
#define XB_XGEN(j)  (2304 + 64 * (j))
#define XB_TOP      3328
#define XB_TOPGEN   3392
#define XCD_BAR_WORDS 3456
#define XB_SPIN_CAP (1u << 18)

__device__ __forceinline__ unsigned xb_ld(unsigned* p)              { return __hip_atomic_load(p, __ATOMIC_RELAXED, __HIP_MEMORY_SCOPE_AGENT); }
__device__ __forceinline__ unsigned xb_add(unsigned* p, unsigned v) { return __hip_atomic_fetch_add(p, v, __ATOMIC_RELAXED, __HIP_MEMORY_SCOPE_AGENT); }
__device__ __forceinline__ unsigned xb_xcc_id() { return (unsigned)__builtin_amdgcn_s_getreg((3 << 11) | 20) & 0xFu; }
#define XB_SPIN(cond, bar) do { unsigned _sp = 0; while (cond) { __builtin_amdgcn_s_sleep(1); \
    if ((++_sp & 255u) == 0u) { if (xb_ld(&(bar)[XB_TMO])) break; if (_sp > XB_SPIN_CAP) { atomicAdd(&(bar)[XB_TMO], 1u); break; } } } } while (0)

struct XcdBarrier {
    unsigned* bar; unsigned x;
    volatile LAS unsigned* st;
};

__device__ __forceinline__ XcdBarrier xcd_barrier_post(unsigned* bar, volatile LAS unsigned* st) {
    XcdBarrier b; b.bar = bar; b.x = xb_xcc_id(); b.st = st;
    if (threadIdx.x == 0) (void)xb_add(&bar[XB_XCNT(b.x)], 1u);
    return b;
}
__device__ __forceinline__ void xcd_barrier_complete(unsigned* bar, unsigned x, unsigned& nloc, unsigned& nx) {
    const unsigned G = gridDim.x * gridDim.y * gridDim.z;
    unsigned sum, cnt, mine, sp = 0u;
    for (;;) {
        sum = 0u; cnt = 0u; mine = 0u;
#pragma unroll
        for (unsigned j = 0; j < 16; ++j) { const unsigned c = xb_ld(&bar[XB_XCNT(j)]); sum += c; cnt += (c > 0u) ? 1u : 0u; mine = (j == x) ? c : mine; }
        if (sum == G) break;
        __builtin_amdgcn_s_sleep(1);
        if ((++sp & 255u) == 0u) { if (xb_ld(&bar[XB_TMO])) break; if (sp > XB_SPIN_CAP) { atomicAdd(&bar[XB_TMO], 1u); break; } }
    }
    nloc = mine > 0u ? mine : 1u; nx = cnt > 0u ? cnt : 1u;
}

__device__ __forceinline__ void xcd_barrier(const XcdBarrier& b) {
    asm volatile("s_waitcnt vmcnt(0)" ::: "memory");
    __syncthreads();
    if (threadIdx.x == 0) {
        unsigned* bar = b.bar;
        __builtin_amdgcn_s_waitcnt(0);
        unsigned nloc = b.st[0], nx = b.st[1];
        if (nloc == 0u) { xcd_barrier_complete(bar, b.x, nloc, nx); b.st[0] = nloc; b.st[1] = nx; }
        const unsigned old = xb_add(&bar[XB_XSUB(b.x)], 1u);
        const unsigned gen = old / nloc;
        if (old + 1u == (gen + 1u) * nloc) {
            __builtin_amdgcn_fence(__ATOMIC_RELEASE, "agent");
            asm volatile("s_waitcnt vmcnt(0)" ::: "memory");
            const unsigned og = xb_add(&bar[XB_TOP], 1u);
            const unsigned tg = og / nx;
            if (og + 1u == (tg + 1u) * nx) xb_add(&bar[XB_TOPGEN], 1u);
            else XB_SPIN(xb_ld(&bar[XB_TOPGEN]) == tg, bar);
            __builtin_amdgcn_fence(__ATOMIC_ACQUIRE, "agent");
            xb_add(&bar[XB_XGEN(b.x)], 1u);
            asm volatile("s_waitcnt vmcnt(0)" ::: "memory");
        } else {
            XB_SPIN(xb_ld(&bar[XB_XGEN(b.x)]) == gen, bar);
            __builtin_amdgcn_fence(__ATOMIC_ACQUIRE, "agent");
            asm volatile("s_waitcnt vmcnt(0)" ::: "memory");
        }
    }
    __syncthreads();
}

enum { OP_PRO = 0, OP_GEMM = 1, OP_SPATIAL = 2, OP_FIX = 3, OP_ATTN = 4, OP_FINAL = 5 };
constexpr int N_OPS = 18;
__host__ __device__ inline int op_kind(int op) {
    switch (op) { case 0: return OP_PRO; case 2: return OP_SPATIAL; case 5: case 13: return OP_FIX; case 10: return OP_ATTN; case 17: return OP_FINAL; default: return OP_GEMM; }
}
__host__ __device__ inline bool op_sync_after(int op) { return !(op == 6 || op == 14 || op == 17); }

__device__ __forceinline__ void make_gemm(int op, PTT PT, pg8::Gemm& g, Epi& E) {
    GAS unsigned char* ws = WSP;
    GAS bf16* HA = (GAS bf16*)(ws + WS_HA); GAS bf16* HB = (GAS bf16*)(ws + WS_HB); GAS bf16* PE = (GAS bf16*)(ws + WS_PE); GAS bf16* BIG = (GAS bf16*)(ws + WS_BIG);
    GAS float* SSQ = (GAS float*)(ws + WS_SSQ); const size_t SS = (size_t)T * 16;
    GAS bf16* ACT = (GAS bf16*)(ws + WS_ACT);
    E.mode = EM_PLAIN; E.out = nullptr; E.ldo = 1024; E.res = nullptr; E.pe = nullptr; E.ssq_in = nullptr; E.ssq_out = nullptr; E.bias = nullptr; E.out_k = nullptr; E.out_v = nullptr; E.cw = nullptr; E.skip = 0; E.par = nullptr;
    g.A = (const pg8::bf16_t*)(nullptr); g.Bt = (const pg8::bf16_t*)(nullptr); g.M = T; g.N = 1024; g.K = 1024; g.aperm = 0;
    const int layer = (op >= 12) ? 1 : 0;
    switch (op) {
        case 1:  g.A = (const pg8::bf16_t*)(HA); g.Bt = (const pg8::bf16_t*)((const GAS bf16*)(ws + WS_WIN)); g.N = 2048; E.mode = EM_GELU; E.out = BIG; E.ldo = 2048; E.ssq_in = SSQ; E.ssq_out = SSQ + SS; break;
        case 3:  g.A = (const pg8::bf16_t*)(BIG + (size_t)T * 2048); g.Bt = (const pg8::bf16_t*)((const GAS bf16*)(ws + WS_WOUT)); E.mode = EM_RES; E.out = HB; E.res = HA; E.ssq_out = SSQ + 2 * SS; break;
        case 4: case 12:
            g.A = (const pg8::bf16_t*)(layer ? HA : HB); g.Bt = (const pg8::bf16_t*)((const GAS bf16*)(ws + WS_WUP) + (size_t)layer * NUP * 1024); g.N = NUP; g.aperm = 1;
            E.mode = EM_UPCONV; E.out = ACT; E.ldo = DFF; E.ssq_in = SSQ + (layer ? 5 : 2) * SS; E.ssq_out = (GAS float*)(ws + WS_RAW);
            E.cw = INP(17) + (size_t)layer * 3 * NUP; E.bias = INP(18) + (size_t)layer * NUP; E.out_k = (GAS bf16*)(ws + 512 * 1024); break;
        case 6: case 14:
            g.A = (const pg8::bf16_t*)(ACT); g.Bt = (const pg8::bf16_t*)((const GAS bf16*)(ws + WS_WDN) + (size_t)layer * 1024 * DFF); g.K = DFF;
            E.mode = EM_RES; E.out = layer ? HB : HA; E.res = layer ? HA : HB; E.ssq_out = SSQ + (layer ? 6 : 3) * SS; break;
        case 7: case 15:
            g.A = (const pg8::bf16_t*)((const GAS bf16*)(ws + WS_PB) + (size_t)layer * T * 256); g.Bt = (const pg8::bf16_t*)((const GAS bf16*)(ws + WS_WPE) + (size_t)layer * 1024 * 256); g.K = 256; E.mode = EM_PLAIN; E.out = PE; break;
        case 8: case 16: {
            const GAS bf16* hin = layer ? HB : HA; GAS bf16* hout = layer ? HA : HB;
            g.A = (const pg8::bf16_t*)(hin); g.Bt = (const pg8::bf16_t*)((const GAS bf16*)(ws + WS_WG) + (size_t)layer * 1024 * 1024); E.mode = EM_GATE; E.out = hout; E.res = hin; E.pe = PE;
            E.ssq_in = SSQ + (layer ? 6 : 3) * SS; E.ssq_out = SSQ + (layer ? 7 : 4) * SS; E.bias = INP(22) + layer * 1024; break; }
        case 9:  g.A = (const pg8::bf16_t*)(HB); g.Bt = (const pg8::bf16_t*)((const GAS bf16*)(ws + WS_WQKV)); g.N = 1536; E.mode = EM_QKV; E.out = BIG; E.out_k = BIG + (size_t)T * 1024; E.out_v = BIG + (size_t)T * 1280; E.ssq_in = SSQ + 4 * SS; break;
        case 11: g.A = (const pg8::bf16_t*)(BIG + (size_t)T * 1536); g.Bt = (const pg8::bf16_t*)((const GAS bf16*)(ws + WS_WO)); E.mode = EM_RES; E.out = HA; E.res = HB; E.ssq_out = SSQ + 5 * SS; break;
        default: break;
    }
}

__global__ void __launch_bounds__(512, 2) fwd_kernel(Args args) {
    extern __shared__ __attribute__((aligned(16))) unsigned char lds_raw[];
    LAS unsigned char* lds = (LAS unsigned char*)lds_raw;
    cg::grid_group grid = cg::this_grid();
    {
        LAS unsigned long long* PW = (LAS unsigned long long*)(lds + 131072);
        if (threadIdx.x == 0) {
#pragma unroll
            for (int i = 0; i < 23; ++i) PW[i] = (unsigned long long)args.in[i];
            PW[23] = (unsigned long long)args.out; PW[24] = (unsigned long long)args.ws;
            ((LAS unsigned*)(lds + 131072 + 512))[0] = 0u; ((LAS unsigned*)(lds + 131072 + 512))[1] = 0u;
        }
        __syncthreads();
    }
    PTT PT = (PTT)(lds + 131072);
    if (threadIdx.x == 0) {
        unsigned* bar0 = (unsigned*)(args.ws + WS_BAR); const unsigned x0 = xb_xcc_id();
        const unsigned rank0 = xb_add(&bar0[XB_XCNT(x0)], 1u);
        ((LAS unsigned*)(lds + 131072 + 512))[2] = x0; ((LAS unsigned*)(lds + 131072 + 512))[3] = rank0;
    }
    __syncthreads();
    for (int op = args.op_lo; op < args.op_hi; ++op) {
        const int kind = op_kind(op);
#if MK_DIAG
        if (blockIdx.x == 0 && threadIdx.x == 0) { GAS unsigned long long* st = (GAS unsigned long long*)(WSP + 4096); st[64 + 2 * op] = (unsigned long long)clock64(); st[65 + 2 * op] = (unsigned long long)wall_clock64(); }
#endif
        for (int rep = 0; rep < ((MK_REP_MASK >> op) & 1u ? 2 : 1); ++rep) {
        if (rep) __syncthreads();
        if (kind == OP_GEMM) {
            pg8::Gemm g; Epi E; make_gemm(op, PT, g, E); E.skip = (rep > 0 && MK_REP_NOEPI) ? 1 : 0; E.par = (LAS float*)(lds + 131072 + 1024);
            pg8::StaticOrder S; S.init(g.M, g.N, (int)gridDim.x, (int)blockIdx.x);
            pg8::gemm_phase<Epi, pg8::StaticOrder, false>(lds, g, S, E, nullptr);
        } else if (kind == OP_PRO) {
            prologue(PT, lds);
        } else if (kind == OP_SPATIAL) {
            spatial_phase(PT, lds);
        } else if (kind == OP_FIX) {
            const int layer = (op >= 12) ? 1 : 0;
            fix_phase((const GAS float*)(WSP + WS_RAW), (GAS bf16*)(WSP + WS_ACT), INP(17) + (size_t)layer * 3 * NUP, INP(18) + (size_t)layer * NUP);
        } else if (kind == OP_ATTN) {
            attn_phase(PT, lds);
        } else {
            final_phase(PT);
        }
        }
#if MK_DIAG
        if (blockIdx.x == 0 && threadIdx.x == 0) { GAS unsigned long long* st = (GAS unsigned long long*)(WSP + 4096); st[2 * op] = (unsigned long long)clock64() - st[64 + 2 * op]; st[1 + 2 * op] = (unsigned long long)wall_clock64() - st[65 + 2 * op]; }
#endif
        if (op_sync_after(op) && op + 1 < args.op_hi) { if (args.op_lo < 0) grid.sync();   XcdBarrier xbar; xbar.bar = (unsigned*)(WSP + WS_BAR); xbar.st = (volatile LAS unsigned*)(lds + 131072 + 512); xbar.x = (unsigned)__builtin_amdgcn_readfirstlane((int)xbar.st[2]); xcd_barrier(xbar); }
        else __syncthreads();
    }
}
}

#ifndef MK_SINGLE
#define MK_SINGLE 1
#endif
#ifndef MK_MAXOP
#define MK_MAXOP N_OPS
#endif
extern "C" void kernel_launch(void* const* d_in, const int* in_sizes, int n_in, void* d_out, int out_size, void* d_ws, size_t ws_size, hipStream_t stream) {
    using namespace mk;
    static int grid = 0;
    if (grid == 0) {
        if (n_in != 23 || ws_size < WS_END) { fprintf(stderr, "kernel_launch: unexpected n_in %d / ws_size %zu\n", n_in, ws_size); grid = -1; return; }
        int dev = 0, cus = 0, per_cu = 0;
        hipGetDevice(&dev); hipDeviceGetAttribute(&cus, hipDeviceAttributeMultiprocessorCount, dev);
        if (hipFuncSetAttribute((const void*)fwd_kernel, hipFuncAttributeMaxDynamicSharedMemorySize, LDS_BYTES) != hipSuccess) { fprintf(stderr, "kernel_launch: hipFuncSetAttribute failed\n"); grid = -1; return; }
        hipOccupancyMaxActiveBlocksPerMultiprocessor(&per_cu, (const void*)fwd_kernel, 512, LDS_BYTES);
        if (per_cu < 1) { fprintf(stderr, "kernel_launch: occupancy query says %d blocks per CU\n", per_cu); per_cu = 1; }
        (void)hipGetLastError();
        grid = cus;
    }
    if (grid < 0) return;
    Args a{};
    for (int i = 0; i < 23; ++i) a.in[i] = (const float*)d_in[i];
    a.out = (float*)d_out; a.ws = (unsigned char*)d_ws;
#if MK_SINGLE
    if (hipMemsetAsync((char*)d_ws + WS_BAR, 0, WS_BAR_BYTES, stream) != hipSuccess) { fprintf(stderr, "kernel_launch: hipMemsetAsync failed\n"); return; }
    a.op_lo = 0; a.op_hi = MK_MAXOP;
    void* kargs[] = {&a};
    hipError_t e = hipLaunchCooperativeKernel((const void*)fwd_kernel, dim3(grid), dim3(512), kargs, LDS_BYTES, stream);
    if (e != hipSuccess) fprintf(stderr, "cooperative launch failed: %s (grid %d)\n", hipGetErrorString(e), grid);
#else
    int lo = 0;
    for (int op = 0; op < MK_MAXOP; ++op) {
        if (op_sync_after(op) || op == MK_MAXOP - 1) {
            a.op_lo = lo; a.op_hi = op + 1; lo = op + 1;
            hipLaunchKernelGGL(fwd_kernel, dim3(grid), dim3(512), LDS_BYTES, stream, a);
        }
    }
#endif
}
```

```cpp
#include <hip/hip_runtime.h>
#include <hip/hip_cooperative_groups.h>
#include <cstdio>
namespace cg = cooperative_groups;
namespace pg8 {
#define PG8_LAS __attribute__((address_space(3)))
typedef unsigned short bf16_t;
typedef short bf16x8 __attribute__((ext_vector_type(8)));
typedef float f32x4 __attribute__((ext_vector_type(4)));
typedef unsigned u32x4 __attribute__((ext_vector_type(4)));
constexpr int BM = 256, BK = 64, HALF = 128, HTB = HALF * BK * 2  , STAGE_BYTES = 8 * HTB, NXCD = 8, WGM = 8;

__host__ __device__ __forceinline__ int lds_byte(int r, int c) { const int st = (r >> 4) * 2 + (c >> 5), rr = r & 15, cc = c & 31, ob = rr * 64 + cc * 2; return st * 1024 + (ob ^ (((ob >> 9) & 1) << 5)); }
__host__ __device__ __forceinline__ void stage_rc(int b, int& R, int& C) { const int st = b / 1024, sb = b % 1024, swz = sb ^ (((sb >> 9) & 1) << 5); R = (st >> 1) * 16 + swz / 64; C = (st & 1) * 32 + (swz % 64) / 2; }
__host__ __device__ __forceinline__ int perm32(int rho) { const int n = rho >> 4, i = rho & 15; return 8 * (i >> 2) + 4 * n + (i & 3); }

struct Unit { int pm, pn; };
struct Gemm { const bf16_t* A; const bf16_t* Bt; int M, N, K, aperm; };

struct StaticOrder {
    int nM, nN, nwg, G, c;
    __host__ __device__ void init(int M, int N, int G_, int c_) { nM = M / BM; nN = N / BM; nwg = nM * nN; G = G_; c = c_; }
    __host__ __device__ bool next(int i, Unit& u) const {
        const long L = (long)i * G + c; if (L >= nwg) return false;
        int wgid = (int)L; { const int q = nwg / NXCD, r = nwg % NXCD, xcd = wgid % NXCD, off = wgid / NXCD; wgid = (xcd < r ? xcd * (q + 1) : r * (q + 1) + (xcd - r) * q) + off; }
        const int nig = WGM * nN, gid = wgid / nig, fm = gid * WGM, gsz = (nM - fm) < WGM ? (nM - fm) : WGM;
        u.pm = fm + ((wgid % nig) % gsz); u.pn = (wgid % nig) / gsz; return true;
    }
    __device__ __forceinline__ void a_ready(const Unit&) const {}
    __device__ __forceinline__ void done(const Unit&) const {}
};
__device__ __forceinline__ unsigned cvt_pk_bf16(float lo, float hi) { unsigned r; asm volatile("v_cvt_pk_bf16_f32 %0, %1, %2" : "=v"(r) : "v"(lo), "v"(hi)); return r; }
typedef float f32x2 __attribute__((ext_vector_type(2)));
template <class Epi, class Sched, bool STAMP = false>
__device__ __forceinline__ void gemm_phase(PG8_LAS unsigned char* lds, const Gemm g, const Sched& S, const Epi& E, unsigned long long* stamps) {
    int tid_ = threadIdx.x; asm volatile("" : "+v"(tid_));
    const int tid = tid_, wid = __builtin_amdgcn_readfirstlane(tid >> 6), lane = tid & 63, wr = wid >> 2, wc = wid & 3, fr = lane & 15, fq = lane >> 4;
    const int K = g.K, nt = K / BK;
    int nts = 0;
    if (STAMP && stamps && tid < 64) { stamps[tid] = 0ull; if (tid == 62) stamps[62] = (unsigned long long)wall_clock64(); }
#define PG8_STAMP() do { if (STAMP && stamps && wid == 0 && nts < 62) { const unsigned long long _c = (unsigned long long)clock64(); if (lane == 0) stamps[nts] = _c; ++nts; } } while (0)
    PG8_STAMP();
    unsigned voffA[2], voffB[2];
#pragma unroll
    for (int i = 0; i < 2; ++i) { int R, C; stage_rc(tid * 16 + i * 8192, R, C); const int Rb = Epi::PERM ? ((R & ~31) + perm32(R & 31)) : R;
        const int Ra = g.aperm ? (((R >> 6) << 7) + (R & 63)) : R;
        voffA[i] = (unsigned)(Ra * K + C) * 2u; voffB[i] = (unsigned)(Rb * K + C) * 2u; }
    const size_t kstep = (size_t)(BK * 2);
    const size_t hstep = (size_t)HALF * K * 2;
    const size_t hstepA = g.aperm ? hstep / 2 : hstep;
    const size_t tstep = 2 * hstep;
    const unsigned ldsw = (unsigned)wid * 1024u;
    const int aoff = lds_byte(wr * 64 + fr, fq * 8), boff = lds_byte(wc * 32 + fr, fq * 8);
#define PG8_SA(b, h) (((b) * 2 + (h)) * HTB)
#define PG8_SB(b, h) ((4 + (b) * 2 + (h)) * HTB)
#define PG8_STAGE(bufoff, gbase, voff) do { _Pragma("unroll") for (int _i = 0; _i < 2; ++_i) \
        __builtin_amdgcn_global_load_lds((const unsigned*)((const char*)(gbase) + (voff)[_i]), (PG8_LAS unsigned*)(lds + (bufoff) + ldsw + _i * 8192), 16, 0, 0); } while (0)
#define PG8_LDA(dst, b, h) do { _Pragma("unroll") for (int m = 0; m < 4; ++m) _Pragma("unroll") for (int k = 0; k < 2; ++k) dst[m][k] = *(const PG8_LAS bf16x8*)(lds + PG8_SA(b, h) + aoff + m * 2048 + k * 1024); } while (0)
#define PG8_LDB(dst, b, h) do { _Pragma("unroll") for (int n = 0; n < 2; ++n) _Pragma("unroll") for (int k = 0; k < 2; ++k) dst[n][k] = *(const PG8_LAS bf16x8*)(lds + PG8_SB(b, h) + boff + n * 2048 + k * 1024); } while (0)
#define PG8_MMA(ai, bj, At, Bt) do { __builtin_amdgcn_s_setprio(1); _Pragma("unroll") for (int m = 0; m < 4; ++m) _Pragma("unroll") for (int n = 0; n < 2; ++n) _Pragma("unroll") for (int k = 0; k < 2; ++k) \
        acc[ai][bj][m][n] = __builtin_amdgcn_mfma_f32_16x16x32_bf16(Bt[n][k], At[m][k], acc[ai][bj][m][n], 0, 0, 0); __builtin_amdgcn_s_setprio(0); } while (0)
#define PG8_WAIT_V(n) asm volatile("s_waitcnt vmcnt(" #n ")" ::: "memory")
#define PG8_WAIT_L(n) asm volatile("s_waitcnt lgkmcnt(" #n ")" ::: "memory")
#define PG8_BAR __builtin_amdgcn_s_barrier()
#define PG8_SCHED __builtin_amdgcn_sched_barrier(0)
    Unit cur, nxt; int ui = 0;
    if (!S.next(0, cur)) return;
    f32x4 acc[2][2][4][2];
#pragma unroll
    for (int a = 0; a < 2; ++a)
#pragma unroll
        for (int b = 0; b < 2; ++b)
#pragma unroll
            for (int m = 0; m < 4; ++m)
#pragma unroll
                for (int n = 0; n < 2; ++n) acc[a][b][m][n] = (f32x4){0.f, 0.f, 0.f, 0.f};
    bf16x8 At[4][2], B0[2][2], B1[2][2];
    const char* cA = (const char*)g.A + (size_t)cur.pm * tstep; const char* cB = (const char*)g.Bt + (size_t)cur.pn * tstep;
    S.a_ready(cur);
    PG8_STAGE(PG8_SB(0, 0), cB, voffB); PG8_STAGE(PG8_SB(0, 1), cB + hstep, voffB); PG8_STAGE(PG8_SA(0, 0), cA, voffA); PG8_STAGE(PG8_SA(0, 1), cA + hstepA, voffA);
    if (wr == 1) PG8_BAR;
    PG8_WAIT_V(2); PG8_BAR;
    PG8_STAGE(PG8_SB(1, 0), cB + kstep, voffB); PG8_STAGE(PG8_SA(1, 0), cA + kstep, voffA); PG8_STAGE(PG8_SB(1, 1), cB + hstep + kstep, voffB);
    PG8_WAIT_V(6); PG8_BAR;
    PG8_STAMP();
    for (;;) {
        const bool has_next = S.next(ui + 1, nxt);
        const char* nA = has_next ? (const char*)g.A + (size_t)nxt.pm * tstep : cA; const char* nB = has_next ? (const char*)g.Bt + (size_t)nxt.pn * tstep : cB;
        for (int t = 0; t < nt; t += 2) {
            const bool last = (t == nt - 2);
            const char* a1 = cA + (size_t)(t + 1) * kstep;
            const char* a2 = last ? nA : cA + (size_t)(t + 2) * kstep; const char* b2 = last ? nB : cB + (size_t)(t + 2) * kstep;
            const char* a3 = a2 + kstep; const char* b3 = b2 + kstep;
            if (last && has_next) S.a_ready(nxt);
            PG8_LDB(B0, 0, 0); PG8_LDB(B1, 0, 1); PG8_SCHED; PG8_LDA(At, 0, 0); PG8_STAGE(PG8_SA(1, 1), a1 + hstepA, voffA);
            PG8_WAIT_V(8); PG8_WAIT_L(0); PG8_BAR; PG8_MMA(0, 0, At, B0); PG8_MMA(0, 1, At, B1); PG8_BAR; PG8_SCHED;
            PG8_LDA(At, 0, 1); PG8_STAGE(PG8_SB(0, 0), b2, voffB); PG8_STAGE(PG8_SB(0, 1), b2 + hstep, voffB); PG8_STAGE(PG8_SA(0, 0), a2, voffA);
            PG8_WAIT_V(8); PG8_WAIT_L(0); PG8_BAR; PG8_MMA(1, 0, At, B0); PG8_MMA(1, 1, At, B1); PG8_BAR; PG8_SCHED;
            PG8_LDB(B0, 1, 0); PG8_LDB(B1, 1, 1); PG8_SCHED; PG8_LDA(At, 1, 0); PG8_STAGE(PG8_SA(0, 1), a2 + hstepA, voffA);
            PG8_WAIT_V(8); PG8_WAIT_L(0); PG8_BAR; PG8_MMA(0, 0, At, B0); PG8_MMA(0, 1, At, B1); PG8_BAR; PG8_SCHED;
            PG8_LDA(At, 1, 1); PG8_STAGE(PG8_SB(1, 0), b3, voffB); PG8_STAGE(PG8_SB(1, 1), b3 + hstep, voffB); PG8_STAGE(PG8_SA(1, 0), a3, voffA);
            PG8_WAIT_V(8); PG8_WAIT_L(0); PG8_BAR; PG8_MMA(1, 0, At, B0); PG8_MMA(1, 1, At, B1); PG8_BAR; PG8_SCHED;
        }
        PG8_STAMP();
        if (wr == 0) PG8_BAR;
        if constexpr (!Epi::AFTER_DRAIN) { E(acc, cur, wr, wc, fr, fq); S.done(cur); }
        PG8_STAMP();
        if (!has_next) break;
#pragma unroll
        for (int a = 0; a < 2; ++a)
#pragma unroll
            for (int b = 0; b < 2; ++b)
#pragma unroll
                for (int m = 0; m < 4; ++m)
#pragma unroll
                    for (int n = 0; n < 2; ++n) acc[a][b][m][n] = (f32x4){0.f, 0.f, 0.f, 0.f};
        cur = nxt; cA = nA; cB = nB; ++ui;
        if (wr == 1) PG8_BAR;
    }
    PG8_WAIT_V(0);
    PG8_BAR;
    if constexpr (Epi::AFTER_DRAIN) { E.fused(acc, cur, wr, wc, fr, fq, lds, wid, lane); S.done(cur); }
    PG8_STAMP();
    if (STAMP && stamps && tid == 0) stamps[63] = (unsigned long long)wall_clock64();
#undef PG8_STAMP
#undef PG8_SA
#undef PG8_SB
#undef PG8_STAGE
#undef PG8_LDA
#undef PG8_LDB
#undef PG8_MMA
#undef PG8_WAIT_V
#undef PG8_WAIT_L
#undef PG8_BAR
#undef PG8_SCHED
}
}

namespace mk {
using pg8::bf16x8; using pg8::f32x4; using pg8::Unit;
#define LAS __attribute__((address_space(3)))
#define GAS __attribute__((address_space(1)))
typedef unsigned short bf16;
typedef unsigned v4u __attribute__((ext_vector_type(4)));
typedef unsigned v2u __attribute__((ext_vector_type(2)));
typedef float f32x16 __attribute__((ext_vector_type(16)));
typedef float f32x2_t __attribute__((ext_vector_type(2)));
typedef __bf16 bf16x2_t __attribute__((ext_vector_type(2)));

constexpr int T = 65536, D = 1024, SEQ = 8192, DFF = 2816, NUP = 5632, TH = 32768  ;
constexpr float EPS = 1e-6f;
constexpr size_t MiB = (size_t)1 << 20;
constexpr size_t WS_WIN = 1 * MiB, WS_WOUT = 5 * MiB, WS_WQKV = 7 * MiB, WS_WO = 10 * MiB, WS_WUP = 12 * MiB, WS_WDN = 34 * MiB, WS_WPE = 45 * MiB, WS_WG = 46 * MiB, WS_WS = 50 * MiB;
constexpr size_t WS_SSQ = 56 * MiB;
constexpr size_t WS_PB = 88 * MiB;
constexpr size_t WS_HA = 152 * MiB, WS_HB = 280 * MiB;
constexpr size_t WS_PE = 808 * MiB;
constexpr size_t WS_BIG = 536 * MiB;
constexpr size_t WS_ACT = 408 * MiB;
constexpr size_t WS_RAW = 760 * MiB;
constexpr size_t WS_END = 1024 * MiB;
constexpr int LDS_BYTES = 147456;
constexpr size_t WS_BAR = 64 * 1024, WS_BAR_BYTES = 16 * 1024;

#ifndef MK_DIAG
#define MK_DIAG 0
#endif
#ifndef MK_DIAG_OP
#define MK_DIAG_OP 4
#endif
#ifndef MK_DIAG_MODE
#define MK_DIAG_MODE 0
#endif
#ifndef MK_DIAG_OP2
#define MK_DIAG_OP2 6
#endif
#ifndef MK_REP_MASK
#define MK_REP_MASK 0u
#endif
#ifndef MK_REP_NOEPI
#define MK_REP_NOEPI 0
#endif
struct Args {
    const float* in[23]; float* out; unsigned char* ws; int op_lo, op_hi;
};
typedef LAS const unsigned long long* PTT;
__device__ __forceinline__ unsigned long long ldp(PTT PT, int i) {
    asm volatile("" ::: "memory");
    const unsigned long long v = PT[i];
    const unsigned lo = __builtin_amdgcn_readfirstlane((unsigned)v), hi = __builtin_amdgcn_readfirstlane((unsigned)(v >> 32));
    return ((unsigned long long)hi << 32) | lo;
}
#define INP(i) ((const GAS float*)ldp(PT, (i)))
#define OUTP ((GAS float*)ldp(PT, 23))
#define WSP ((GAS unsigned char*)ldp(PT, 24))

__device__ __forceinline__ int opaque_tid() { int t = threadIdx.x; asm volatile("" : "+v"(t)); return t; }
__device__ __forceinline__ int opaque_bid() { int b = blockIdx.x; asm volatile("" : "+s"(b)); return b; }
__device__ __forceinline__ unsigned f2bf(float f) { unsigned u = __builtin_bit_cast(unsigned, f); return (u + 0x7fffu + ((u >> 16) & 1u)) >> 16; }
__device__ __forceinline__ unsigned pk2(float lo, float hi) { f32x2_t v = {lo, hi}; bf16x2_t b = __builtin_convertvector(v, bf16x2_t); return __builtin_bit_cast(unsigned, b); }
__device__ __forceinline__ float bflo(unsigned w) { return __builtin_bit_cast(float, w << 16); }
__device__ __forceinline__ float bfhi(unsigned w) { return __builtin_bit_cast(float, w & 0xffff0000u); }
__device__ __forceinline__ float bf2f(bf16 b) { return __builtin_bit_cast(float, ((unsigned)b) << 16); }
__device__ __forceinline__ float fast_sigmoid(float x) { return __builtin_amdgcn_rcpf(1.0f + __expf(-x)); }
__device__ __forceinline__ float gelu_tanh(float x) { const float y = x * (1.5957691216f + 0.0713548163f * x * x); return x * __builtin_amdgcn_rcpf(1.0f + __expf(-y)); }
__device__ __forceinline__ float row_rstd(const GAS float* ssq, size_t row) {
    const f32x4 a = *(const GAS f32x4*)(ssq + (row) * 4), b = *(const GAS f32x4*)(ssq + ((size_t)T + row) * 4), c = *(const GAS f32x4*)(ssq + ((size_t)2 * T + row) * 4), d = *(const GAS f32x4*)(ssq + ((size_t)3 * T + row) * 4);
    const float s = ((a[0] + a[1]) + (a[2] + a[3])) + ((b[0] + b[1]) + (b[2] + b[3])) + ((c[0] + c[1]) + (c[2] + c[3])) + ((d[0] + d[1]) + (d[2] + d[3]));
    return rsqrtf(s * (1.0f / 1024.0f) + EPS);
}
__device__ __forceinline__ float wave_sum(float v) {
#pragma unroll
    for (int o = 1; o < 64; o <<= 1) v += __shfl_xor(v, o);
    return v;
}

template <bool APERM> __device__ __forceinline__ void wave_rstd8(const GAS float* ssq, int rowbase, int fq, float (&rs)[8]) {
    f32x4 v[8];
#pragma unroll
    for (int q = 0; q < 8; ++q) { const int row = rowbase + (APERM ? 16 * q : (q >> 2) * 128 + (q & 3) * 16); v[q] = *(const GAS f32x4*)(ssq + ((size_t)fq * T + (size_t)row) * 4); }
#pragma unroll
    for (int q = 0; q < 8; ++q) { float t = (v[q][0] + v[q][1]) + (v[q][2] + v[q][3]); t += __shfl_xor(t, 16); t += __shfl_xor(t, 32); rs[q] = rsqrtf(t * (1.0f / 1024.0f) + EPS); }
}

enum { EM_PLAIN = 0, EM_GELU = 1, EM_RES = 2, EM_SCALE = 3, EM_GATE = 4, EM_QKV = 5, EM_UPCONV = 6 };
__device__ __forceinline__ float dpp_ror1(float x) { return __builtin_bit_cast(float, __builtin_amdgcn_mov_dpp(__builtin_bit_cast(int, x), 0x121, 0xf, 0xf, false)); }
__device__ __forceinline__ float dpp_ror2(float x) { return __builtin_bit_cast(float, __builtin_amdgcn_mov_dpp(__builtin_bit_cast(int, x), 0x122, 0xf, 0xf, false)); }
struct Epi {
    static constexpr bool PERM = true, AFTER_DRAIN = false;
    int mode; GAS bf16* out; int ldo; const GAS bf16* res; const GAS bf16* pe; const GAS float* ssq_in; GAS float* ssq_out; const GAS float* bias; GAS bf16* out_k; GAS bf16* out_v; const GAS float* cw; int skip; LAS float* par;
    __device__ __forceinline__ void upconv(f32x4 (&acc)[2][2][4][2], const Unit& u, int wr, int wc, int fr, int fq) const {
        const int tok0 = u.pm * 256 + wr * 128, jc = u.pn * 128 + wc * 32 + 8 * fq, lane = fq * 16 + fr, wid = wr * 4 + wc;
        const int pa = lane >> 3, pc = 4 * (lane & 7);
        const GAS float* psrc = ((pa < 6) ? cw + (pa % 3) * NUP + ((pa >= 3) ? DFF : 0) : bias + ((pa == 7) ? DFF : 0)) + u.pn * 128 + wc * 32 + pc;
        const f32x4 pv = *(const GAS f32x4*)psrc;
        float rs[8]; wave_rstd8<true>(ssq_in, tok0 + fr, fq, rs);
        LAS float* P = par + wid * 256;
        *(LAS f32x4*)(P + pa * 32 + pc) = pv;
#pragma unroll
        for (int q = 0; q < 8; ++q) { acc[q >> 2][0][q & 3][0] *= rs[q]; acc[q >> 2][0][q & 3][1] *= rs[q]; acc[q >> 2][1][q & 3][0] *= rs[q]; acc[q >> 2][1][q & 3][1] *= rs[q]; }
        GAS float* rawg = ssq_out + (size_t)(2 * u.pm + wr) * 4 * NUP + jc;
        GAS float* dumw = (GAS float*)out_k + (size_t)(blockIdx.x * 8 + wid) * 32;
        { GAS float* pg = (fr < 2) ? rawg + fr * NUP : dumw; GAS float* pu = (fr < 2) ? pg + DFF : dumw + 16;
          *(GAS f32x4*)pg = acc[0][0][0][0]; *(GAS f32x4*)(pg + 4) = acc[0][0][0][1]; *(GAS f32x4*)pu = acc[0][1][0][0]; *(GAS f32x4*)(pu + 4) = acc[0][1][0][1]; }
        { GAS float* pg = (fr >= 14) ? rawg + (fr - 12) * NUP : dumw; GAS float* pu = (fr >= 14) ? pg + DFF : dumw + 16;
          *(GAS f32x4*)pg = acc[1][0][3][0]; *(GAS f32x4*)(pg + 4) = acc[1][0][3][1]; *(GAS f32x4*)pu = acc[1][1][3][0]; *(GAS f32x4*)(pu + 4) = acc[1][1][3][1]; }
        asm volatile("" ::: "memory");
        const bool f1 = fr >= 1, f2 = fr >= 2;
#pragma unroll
        for (int n = 0; n < 2; ++n) {
            unsigned ow[8][2];
#pragma unroll
            for (int kp = 0; kp < 2; ++kp) {
                const LAS float* Pc = P + 8 * fq + 4 * n + 2 * kp;
                const f32x2_t wg0 = *(const LAS f32x2_t*)(Pc), wg1 = *(const LAS f32x2_t*)(Pc + 32), wg2 = *(const LAS f32x2_t*)(Pc + 64);
                const f32x2_t wu0 = *(const LAS f32x2_t*)(Pc + 96), wu1 = *(const LAS f32x2_t*)(Pc + 128), wu2 = *(const LAS f32x2_t*)(Pc + 160);
                const f32x2_t bg = *(const LAS f32x2_t*)(Pc + 192), bu = *(const LAS f32x2_t*)(Pc + 224);
                float r0[8];
#pragma unroll
                for (int kk = 0; kk < 2; ++kk) {
                    const int k = 2 * kp + kk;
                    float g1p = 0.f, g2p = 0.f, u1p = 0.f, u2p = 0.f;
#pragma unroll
                    for (int q = 0; q < 8; ++q) {
                        const float g = acc[q >> 2][0][q & 3][n][k], uu = acc[q >> 2][1][q & 3][n][k];
                        const float g1 = dpp_ror1(g), g2 = dpp_ror2(g), u1 = dpp_ror1(uu), u2 = dpp_ror2(uu);
                        const float pg1 = f1 ? g1 : g1p, pg2 = f2 ? g2 : g2p, pu1 = f1 ? u1 : u1p, pu2 = f2 ? u2 : u2p;
                        const float cg = bg[kk] + wg0[kk] * pg2 + wg1[kk] * pg1 + wg2[kk] * g;
                        const float cu = bu[kk] + wu0[kk] * pu2 + wu1[kk] * pu1 + wu2[kk] * uu;
                        const float res = cg * fast_sigmoid(cg) * cu;
                        if (kk == 0) r0[q] = res; else ow[q][kp] = pk2(r0[q], res);
                        g1p = g1; g2p = g2; u1p = u1; u2p = u2;
                    }
                }
                asm volatile("" ::: "memory");
            }
#pragma unroll
            for (int q = 0; q < 8; ++q) { v2u w; w.x = ow[q][0]; w.y = ow[q][1]; *(GAS v2u*)(out + (size_t)(tok0 + 16 * q + fr) * DFF + jc + 4 * n) = w; }
            asm volatile("" ::: "memory");
        }
    }
    __device__ __forceinline__ void operator()(f32x4 (&acc)[2][2][4][2], const Unit& u, int wr, int wc, int fr, int fq) const {
        if (MK_REP_MASK != 0u && skip) return;
        if (mode == EM_UPCONV) { upconv(acc, u, wr, wc, fr, fq); return; }
        const int row0 = u.pm * 256 + wr * 64 + fr;
        const int colt = u.pn * 256, cw = wc * 32 + 8 * fq;
        GAS bf16* obase = out; int old = ldo, ocol = colt;
        if (mode == EM_QKV) { if (u.pn == 4) { obase = out_k; old = 256; ocol = 0; } else if (u.pn == 5) { obase = out_v; old = 256; ocol = 0; } }
        const bool use_rs = (mode == EM_GELU) | (mode == EM_SCALE) | (mode == EM_GATE) | (mode == EM_QKV);
        const bool do_ssq = (mode == EM_RES) | (mode == EM_GATE) | ((mode == EM_GELU) & (u.pn >= 4));
        const unsigned slotbase = (unsigned)((mode == EM_GELU) ? (u.pn - 4) : u.pn) * (unsigned)T;
        float rsv[8];
        if (use_rs) wave_rstd8<false>(ssq_in, row0, fq, rsv);
        else {
#pragma unroll
            for (int q = 0; q < 8; ++q) rsv[q] = 1.0f; }
        LAS float* Pb = par + (wr * 4 + wc) * 256;
        if (mode == EM_GATE) {
            const int l16 = fq * 16 + fr;
            if (l16 < 16) *(LAS f32x4*)(Pb + (l16 >> 3) * 32 + 4 * (l16 & 7)) = *(const GAS f32x4*)(bias + colt + (l16 >> 3) * 128 + wc * 32 + 4 * (l16 & 7));
        }
#pragma unroll
        for (int aq = 0; aq < 4; ++aq) {
            const int ai = aq >> 1, m0 = (aq & 1) * 2;
            v4u rr[2][2], ee[2][2];
            if ((mode == EM_RES) | (mode == EM_GATE)) {
#pragma unroll
                for (int mm = 0; mm < 2; ++mm)
#pragma unroll
                    for (int bj = 0; bj < 2; ++bj) rr[mm][bj] = *(const GAS v4u*)(res + ((unsigned)(row0 + ai * 128 + (m0 + mm) * 16) * 1024u + (unsigned)(colt + bj * 128 + cw)));
            }
            if (mode == EM_GATE) {
#pragma unroll
                for (int mm = 0; mm < 2; ++mm)
#pragma unroll
                    for (int bj = 0; bj < 2; ++bj) ee[mm][bj] = *(const GAS v4u*)(pe + ((unsigned)(row0 + ai * 128 + (m0 + mm) * 16) * 1024u + (unsigned)(colt + bj * 128 + cw)));
            }
            __builtin_amdgcn_sched_barrier(0);
#pragma unroll
            for (int mm = 0; mm < 2; ++mm) {
                const int m = m0 + mm;
                const unsigned row = (unsigned)(row0 + ai * 128 + m * 16);
                const float rs = rsv[ai * 4 + m];
                float sq = 0.f;
#pragma unroll
                for (int bj = 0; bj < 2; ++bj) {
                    f32x4 v0 = acc[ai][bj][m][0] * rs, v1 = acc[ai][bj][m][1] * rs;
                    if (mode == EM_GELU) {
#pragma unroll
                        for (int j = 0; j < 4; ++j) { v0[j] = gelu_tanh(v0[j]); v1[j] = gelu_tanh(v1[j]); }
                    } else if (mode == EM_RES) {
                        const v4u r = rr[mm][bj];
                        v0[0] += bflo(r.x); v0[1] += bfhi(r.x); v0[2] += bflo(r.y); v0[3] += bfhi(r.y);
                        v1[0] += bflo(r.z); v1[1] += bfhi(r.z); v1[2] += bflo(r.w); v1[3] += bfhi(r.w);
                    } else if (mode == EM_GATE) {
                        const v4u r = rr[mm][bj], e = ee[mm][bj];
                        const f32x4 b0 = *(const LAS f32x4*)(Pb + bj * 32 + 8 * fq), b1 = *(const LAS f32x4*)(Pb + bj * 32 + 8 * fq + 4);
                        v0[0] = bflo(r.x) + bflo(e.x) * fast_sigmoid(v0[0] + b0[0]); v0[1] = bfhi(r.x) + bfhi(e.x) * fast_sigmoid(v0[1] + b0[1]);
                        v0[2] = bflo(r.y) + bflo(e.y) * fast_sigmoid(v0[2] + b0[2]); v0[3] = bfhi(r.y) + bfhi(e.y) * fast_sigmoid(v0[3] + b0[3]);
                        v1[0] = bflo(r.z) + bflo(e.z) * fast_sigmoid(v1[0] + b1[0]); v1[1] = bfhi(r.z) + bfhi(e.z) * fast_sigmoid(v1[1] + b1[1]);
                        v1[2] = bflo(r.w) + bflo(e.w) * fast_sigmoid(v1[2] + b1[2]); v1[3] = bfhi(r.w) + bfhi(e.w) * fast_sigmoid(v1[3] + b1[3]);
                    }
                    sq += (v0[0] * v0[0] + v0[1] * v0[1]) + (v0[2] * v0[2] + v0[3] * v0[3]) + (v1[0] * v1[0] + v1[1] * v1[1]) + (v1[2] * v1[2] + v1[3] * v1[3]);
                    v4u w; w.x = pk2(v0[0], v0[1]); w.y = pk2(v0[2], v0[3]); w.z = pk2(v1[0], v1[1]); w.w = pk2(v1[2], v1[3]);
                    *(GAS v4u*)(obase + (row * (unsigned)old + (unsigned)(ocol + bj * 128 + cw))) = w;
                }
                if (do_ssq) {
                    sq += __shfl_xor(sq, 16); sq += __shfl_xor(sq, 32);
                    if (fq == 0) ssq_out[(slotbase + row) * 4u + (unsigned)wc] = sq;
                }
            }
            __builtin_amdgcn_sched_barrier(0);
        }
    }
};

__device__ __forceinline__ void transpose_item(const GAS float* W, int K, int N, GAS bf16* WT, int row_off, const GAS float* gain, LAS float* scr, int item, int lane, bool upperm) {
    const int nblk = N / 32, kb = item / nblk, nb = item % nblk, k0 = 64 * kb, n0 = 32 * nb;
    int r0 = row_off + n0;
    if (upperm) { const int bj = (n0 >= DFF) ? 1 : 0, ci = n0 - DFF * bj; r0 = 256 * (ci >> 7) + 128 * bj + (ci & 127); }
#pragma unroll 16
    for (int i = 0; i < 32; ++i) { const int kk = 2 * i + (lane >> 5); const float gsc = gain ? gain[k0 + kk] : 1.0f; scr[kk * 33 + (lane & 31)] = W[(size_t)(k0 + kk) * N + n0 + (lane & 31)] * gsc; }
    asm volatile("s_waitcnt lgkmcnt(0)" ::: "memory");
    const int c = lane & 7;
#pragma unroll
    for (int j = 0; j < 4; ++j) { const int n = (lane >> 3) + 8 * j; const LAS float* s = scr + (8 * c) * 33 + n;
        v4u o; o.x = pk2(s[0 * 33], s[1 * 33]); o.y = pk2(s[2 * 33], s[3 * 33]); o.z = pk2(s[4 * 33], s[5 * 33]); o.w = pk2(s[6 * 33], s[7 * 33]);
        *(GAS v4u*)(WT + (size_t)(r0 + n) * K + k0 + 8 * c) = o; }
    asm volatile("s_waitcnt lgkmcnt(0)" ::: "memory");
}

__device__ __forceinline__ void prologue(PTT PT, LAS unsigned char* lds) {
    const int tid = opaque_tid(), bid = opaque_bid(), lane = tid & 63, wave = tid >> 6;
    const int gw = bid * 8 + wave, NGW = gridDim.x * 8;
    LAS float* scr = (LAS float*)(lds + wave * 16384);
    GAS unsigned char* ws = WSP;
    if (wave & 1) {
        const int tw = bid * 4 + (wave >> 1), NTW = gridDim.x * 4;
        for (int gi = tw; gi < 12544; gi += NTW) {
            const GAS float* W; int K, N, ro = 0, it = gi, mi; GAS bf16* WT; const GAS float* gain = nullptr;
            if (gi < 1024) { mi = 0; W = INP(7); K = 1024; N = 2048; WT = (GAS bf16*)(ws + WS_WIN); gain = INP(2); }
            else if (gi < 1536) { mi = 1; it = gi - 1024; W = INP(11); K = 1024; N = 1024; WT = (GAS bf16*)(ws + WS_WOUT); }
            else if (gi < 2048) { mi = 2; it = gi - 1536; W = INP(13); K = 1024; N = 1024; WT = (GAS bf16*)(ws + WS_WQKV); gain = INP(2) + 1024; }
            else if (gi < 2304) { mi = 3; it = gi - 2048; W = INP(12); K = 1024; N = 512; WT = (GAS bf16*)(ws + WS_WQKV); ro = 1024; gain = INP(5); }
            else if (gi < 2816) { mi = 4; it = gi - 2304; W = INP(15); K = 1024; N = 1024; WT = (GAS bf16*)(ws + WS_WO); }
            else if (gi < 5632) { mi = 5; it = gi - 2816; W = INP(16); K = 1024; N = NUP; WT = (GAS bf16*)(ws + WS_WUP); gain = INP(3); }
            else if (gi < 8448) { mi = 6; it = gi - 5632; W = INP(16) + (size_t)1024 * NUP; K = 1024; N = NUP; WT = (GAS bf16*)(ws + WS_WUP) + (size_t)NUP * 1024; gain = INP(3) + 1024; }
            else if (gi < 9856) { mi = 7; it = gi - 8448; W = INP(19); K = DFF; N = 1024; WT = (GAS bf16*)(ws + WS_WDN); }
            else if (gi < 11264) { mi = 8; it = gi - 9856; W = INP(19) + (size_t)DFF * 1024; K = DFF; N = 1024; WT = (GAS bf16*)(ws + WS_WDN) + (size_t)1024 * DFF; }
            else if (gi < 11392) { mi = 9; it = gi - 11264; W = INP(20); K = 256; N = 1024; WT = (GAS bf16*)(ws + WS_WPE); }
            else if (gi < 11520) { mi = 10; it = gi - 11392; W = INP(20) + (size_t)256 * 1024; K = 256; N = 1024; WT = (GAS bf16*)(ws + WS_WPE) + (size_t)1024 * 256; }
            else if (gi < 12032) { mi = 11; it = gi - 11520; W = INP(21); K = 1024; N = 1024; WT = (GAS bf16*)(ws + WS_WG); gain = INP(4); }
            else { mi = 12; it = gi - 12032; W = INP(21) + (size_t)1024 * 1024; K = 1024; N = 1024; WT = (GAS bf16*)(ws + WS_WG) + (size_t)1024 * 1024; gain = INP(4) + 1024; }
            transpose_item(W, K, N, WT, ro, gain, scr, it, lane, mi == 5 || mi == 6);
        }
    }
    {
        const GAS float* w = INP(9); GAS bf16* o = (GAS bf16*)(ws + WS_WS);
        for (int i = bid * 512 + tid; i < 8 * 128 * 128; i += gridDim.x * 512) { const int s = i & 127, t = (i >> 7) & 127; o[i] = (bf16)f2bf(s <= t ? w[i] : 0.0f); }
    }
    {
        const GAS float* x = INP(0); GAS bf16* xb = (GAS bf16*)(ws + WS_HA); GAS float* ssq0 = (GAS float*)(ws + WS_SSQ);
        if (!(wave & 1))
#pragma unroll 8
        for (int r = bid * 4 + (wave >> 1); r < T; r += gridDim.x * 4) {
            const GAS f32x4* xr = (const GAS f32x4*)(x + (size_t)r * D) + lane; float s = 0.f;
            GAS unsigned long long* o8 = (GAS unsigned long long*)(xb + (size_t)r * D) + lane;
#pragma unroll
            for (int j = 0; j < 4; ++j) { const f32x4 v = xr[64 * j]; s += (v[0] * v[0] + v[1] * v[1]) + (v[2] * v[2] + v[3] * v[3]);
                o8[64 * j] = (unsigned long long)pk2(v[0], v[1]) | ((unsigned long long)pk2(v[2], v[3]) << 32); }
            s = wave_sum(s);
            if (lane < 16) ssq0[((size_t)(lane >> 2) * T + (size_t)r) * 4 + (lane & 3)] = (lane == 0) ? s : 0.f;
        }
    }
    {
        const GAS f32x4* p4 = (const GAS f32x4*)INP(1); GAS unsigned long long* o8 = (GAS unsigned long long*)(ws + WS_PB);
        const size_t n4 = (size_t)2 * T * 256 / 4;
#pragma unroll 8
        for (size_t i = (size_t)bid * 512 + tid; i < n4; i += (size_t)gridDim.x * 512) { const f32x4 v = p4[i]; o8[i] = (unsigned long long)pk2(v[0], v[1]) | ((unsigned long long)pk2(v[2], v[3]) << 32); }
    }
}

__device__ __forceinline__ void spatial_phase(PTT PT, LAS unsigned char* lds) {
    const int tid = opaque_tid(), bid = opaque_bid(), lane = tid & 63, wave = __builtin_amdgcn_readfirstlane(tid >> 6), r = lane & 31, hh = lane >> 5;
    GAS unsigned char* ws = WSP;
    const GAS bf16* z = (const GAS bf16*)(ws + WS_BIG); GAS bf16* us = (GAS bf16*)(ws + WS_BIG + 256 * MiB);
    const GAS float* ssq1 = (const GAS float*)(ws + WS_SSQ + 1 * 4 * MiB);
    const GAS bf16* Wsb = (const GAS bf16*)(ws + WS_WS);
    const GAS float* gv = INP(8); const GAS float* bs = INP(10);
    LAS unsigned* vT32 = (LAS unsigned*)lds;
    LAS unsigned char* vTb = lds;
    const int tt = wave >> 1, dd0 = (wave & 1) * 2, p = tid & 63;
    int hcur = -1; bf16x8 af[8]; float biasv[16]; f32x4 gg[2][2];
    v4u nva[2], nvb[2]; float nrsa = 0.f, nrsb = 0.f;
#define SP_FETCH(UU) do { const int h_ = (UU) & 7, c_ = (UU) >> 3; const size_t ra_ = (size_t)c_ * 128 + 2 * p, rb_ = ra_ + 1; \
        nrsa = row_rstd(ssq1, ra_); nrsb = row_rstd(ssq1, rb_); \
        _Pragma("unroll") for (int it = 0; it < 2; ++it) { const int cc = (tid >> 6) + 8 * it; \
            nva[it] = *(const GAS v4u*)(z + ra_ * 2048 + 1024 + h_ * 128 + cc * 8); nvb[it] = *(const GAS v4u*)(z + rb_ * 2048 + 1024 + h_ * 128 + cc * 8); } } while (0)
    if (bid < 4096) SP_FETCH(bid);
    for (int u = bid; u < 4096; u += gridDim.x) {
        const int h = u & 7, c = u >> 3; const size_t tok0 = (size_t)c * 128;
        if (h != hcur) {
            hcur = h;
            const GAS bf16* wrow = Wsb + ((size_t)(h * 128 + 32 * tt + r)) * 128 + 8 * hh;
#pragma unroll
            for (int ks = 0; ks < 8; ++ks) af[ks] = *(const GAS bf16x8*)(wrow + 16 * ks);
#pragma unroll
            for (int reg = 0; reg < 16; ++reg) biasv[reg] = bs[h * 128 + 32 * tt + (reg & 3) + 8 * (reg >> 2) + 4 * hh];
#pragma unroll
            for (int it = 0; it < 2; ++it) { const int cc = (tid >> 6) + 8 * it; gg[it][0] = *(const GAS f32x4*)(gv + h * 128 + cc * 8); gg[it][1] = *(const GAS f32x4*)(gv + h * 128 + cc * 8 + 4); }
        }
        __syncthreads();
#pragma unroll
        for (int it = 0; it < 2; ++it) {
            const int cc = (tid >> 6) + 8 * it;
            const v4u va = nva[it], vb = nvb[it]; const f32x4 g0 = gg[it][0], g1 = gg[it][1]; const float rsa = nrsa, rsb = nrsb;
            LAS unsigned* dst = vT32 + (cc * 8) * 68 + p;
            dst[0 * 68] = pk2(bflo(va.x) * rsa * g0[0], bflo(vb.x) * rsb * g0[0]);
            dst[1 * 68] = pk2(bfhi(va.x) * rsa * g0[1], bfhi(vb.x) * rsb * g0[1]);
            dst[2 * 68] = pk2(bflo(va.y) * rsa * g0[2], bflo(vb.y) * rsb * g0[2]);
            dst[3 * 68] = pk2(bfhi(va.y) * rsa * g0[3], bfhi(vb.y) * rsb * g0[3]);
            dst[4 * 68] = pk2(bflo(va.z) * rsa * g1[0], bflo(vb.z) * rsb * g1[0]);
            dst[5 * 68] = pk2(bfhi(va.z) * rsa * g1[1], bfhi(vb.z) * rsb * g1[1]);
            dst[6 * 68] = pk2(bflo(va.w) * rsa * g1[2], bflo(vb.w) * rsb * g1[2]);
            dst[7 * 68] = pk2(bfhi(va.w) * rsa * g1[3], bfhi(vb.w) * rsb * g1[3]);
        }
        __syncthreads();
        if (u + (int)gridDim.x < 4096) SP_FETCH(u + (int)gridDim.x);
        bf16 uv0[16], uv1[16];
#pragma unroll
        for (int reg = 0; reg < 16; ++reg) { const size_t tok = tok0 + 32 * tt + (reg & 3) + 8 * (reg >> 2) + 4 * hh; const int ch = h * 128 + 32 * dd0 + r;
            uv0[reg] = z[tok * 2048 + ch]; uv1[reg] = z[tok * 2048 + ch + 32]; }
        f32x16 acc0, acc1;
#pragma unroll
        for (int i = 0; i < 16; ++i) { acc0[i] = 0.f; acc1[i] = 0.f; }
        const LAS unsigned char* b0p = vTb + (32 * dd0 + r) * 272 + 16 * hh, * b1p = b0p + 32 * 272;
        const int nks = 2 * tt + 2;
#pragma unroll
        for (int ks = 0; ks < 8; ++ks) {
            if (ks < nks) {
                const bf16x8 bf0 = *(const LAS bf16x8*)(b0p + 32 * ks), bf1 = *(const LAS bf16x8*)(b1p + 32 * ks);
                acc0 = __builtin_amdgcn_mfma_f32_32x32x16_bf16(af[ks], bf0, acc0, 0, 0, 0);
                acc1 = __builtin_amdgcn_mfma_f32_32x32x16_bf16(af[ks], bf1, acc1, 0, 0, 0);
            }
        }
#pragma unroll
        for (int reg = 0; reg < 16; ++reg) {
            const int t = 32 * tt + (reg & 3) + 8 * (reg >> 2) + 4 * hh;
            const size_t tok = tok0 + t; const int ch = h * 128 + 32 * dd0 + r;
            const float u0 = bf2f(uv0[reg]), u1 = bf2f(uv1[reg]);
            us[tok * 1024 + ch] = (bf16)f2bf(u0 * (acc0[reg] + biasv[reg]));
            us[tok * 1024 + ch + 32] = (bf16)f2bf(u1 * (acc1[reg] + biasv[reg]));
        }
    }
#undef SP_FETCH
}

__device__ __forceinline__ void fix_phase(const GAS float* raw, GAS bf16* act, const GAS float* cw, const GAS float* cb) {
    constexpr int NC4 = DFF / 4;
    const int nitems = 512 * NC4;
    for (int it = opaque_bid() * 512 + opaque_tid(); it < nitems; it += gridDim.x * 512) {
        const int grp = it / NC4, c4 = (it % NC4) * 4;
        const f32x4 wg0 = *(const GAS f32x4*)(cw + c4), wg1 = *(const GAS f32x4*)(cw + NUP + c4), wg2 = *(const GAS f32x4*)(cw + 2 * NUP + c4);
        const f32x4 wu0 = *(const GAS f32x4*)(cw + DFF + c4), wu1 = *(const GAS f32x4*)(cw + NUP + DFF + c4), wu2 = *(const GAS f32x4*)(cw + 2 * NUP + DFF + c4);
        const f32x4 bg = *(const GAS f32x4*)(cb + c4), bu = *(const GAS f32x4*)(cb + DFF + c4);
        const GAS float* rc = raw + (size_t)grp * 4 * NUP + c4;
        const f32x4 g0 = *(const GAS f32x4*)(rc), u0 = *(const GAS f32x4*)(rc + DFF), g1 = *(const GAS f32x4*)(rc + NUP), u1 = *(const GAS f32x4*)(rc + NUP + DFF);
        f32x4 gm2 = {0.f, 0.f, 0.f, 0.f}, gm1 = gm2, um2 = gm2, um1 = gm2;
        if ((grp & 63) != 0) { const GAS float* rp = rc - 4 * NUP; gm2 = *(const GAS f32x4*)(rp + 2 * NUP); um2 = *(const GAS f32x4*)(rp + 2 * NUP + DFF); gm1 = *(const GAS f32x4*)(rp + 3 * NUP); um1 = *(const GAS f32x4*)(rp + 3 * NUP + DFF); }
        float a0[4], a1[4];
#pragma unroll
        for (int k = 0; k < 4; ++k) {
            const float cg0 = bg[k] + wg0[k] * gm2[k] + wg1[k] * gm1[k] + wg2[k] * g0[k], cu0 = bu[k] + wu0[k] * um2[k] + wu1[k] * um1[k] + wu2[k] * u0[k];
            const float cg1 = bg[k] + wg0[k] * gm1[k] + wg1[k] * g0[k] + wg2[k] * g1[k], cu1 = bu[k] + wu0[k] * um1[k] + wu1[k] * u0[k] + wu2[k] * u1[k];
            a0[k] = cg0 * fast_sigmoid(cg0) * cu0; a1[k] = cg1 * fast_sigmoid(cg1) * cu1;
        }
        v2u w0, w1; w0.x = pk2(a0[0], a0[1]); w0.y = pk2(a0[2], a0[3]); w1.x = pk2(a1[0], a1[1]); w1.y = pk2(a1[2], a1[3]);
        GAS bf16* ar = act + (size_t)grp * 128 * DFF + c4;
        *(GAS v2u*)ar = w0; *(GAS v2u*)(ar + DFF) = w1;
    }
}

__device__ __forceinline__ void attn_phase(PTT PT, LAS unsigned char* lds) {
    const int tid = opaque_tid(), bid = opaque_bid(), lane = tid & 63, wave = __builtin_amdgcn_readfirstlane(tid >> 6), r = lane & 31, hh = lane >> 5;
    GAS unsigned char* ws = WSP;
    const GAS bf16* qb = (const GAS bf16*)(ws + WS_BIG); const GAS bf16* kb = (const GAS bf16*)(ws + WS_BIG + 128 * MiB); const GAS bf16* vb = (const GAS bf16*)(ws + WS_BIG + 160 * MiB);
    GAS bf16* ao = (GAS bf16*)(ws + WS_BIG + 192 * MiB);
    const GAS float* sinks = INP(14);
    LAS unsigned char* Ks = lds;
    LAS unsigned* Vt32 = (LAS unsigned*)(lds + 36864);
    LAS unsigned char* Vtb = lds + 36864;
    v4u kreg[4], vreg[2][2]; bf16x8 qn[2][4];
#define ATTN_FETCH(UU) do { const int kvh_ = (UU) & 3, nb_ = ((UU) >> 2) & 63, b_ = (UU) >> 8; const long t0_ = (long)b_ * SEQ + (long)nb_ * 128; \
        _Pragma("unroll") for (int it = 0; it < 4; ++it) { const int idx = tid + 512 * it, row = idx >> 3, c = idx & 7; const long tok = t0_ - 128 + row; \
            v4u val = {0u, 0u, 0u, 0u}; if (nb_ > 0 || row >= 128) val = *(const GAS v4u*)(kb + tok * 256 + kvh_ * 64 + c * 8); kreg[it] = val; } \
        _Pragma("unroll") for (int it = 0; it < 2; ++it) { const int p = tid & 127, c = (tid >> 7) + 4 * it; const long tok = t0_ - 128 + 2 * p; \
            v4u va = {0u, 0u, 0u, 0u}, vbv = va; if (nb_ > 0 || p >= 64) { va = *(const GAS v4u*)(vb + tok * 256 + kvh_ * 64 + c * 8); vbv = *(const GAS v4u*)(vb + (tok + 1) * 256 + kvh_ * 64 + c * 8); } \
            vreg[it][0] = va; vreg[it][1] = vbv; } \
        _Pragma("unroll") for (int i_ = 0; i_ < 2; ++i_) { const int wu_ = wave + 8 * i_; const GAS bf16* qrow_ = qb + (size_t)(t0_ + 32 * (wu_ >> 2) + r) * 1024 + (kvh_ * 4 + (wu_ & 3)) * 64 + 8 * hh; \
            _Pragma("unroll") for (int ks = 0; ks < 4; ++ks) qn[i_][ks] = *(const GAS bf16x8*)(qrow_ + 16 * ks); } } while (0)
    if (bid < 2048) ATTN_FETCH(bid);
    for (int u = bid; u < 2048; u += gridDim.x) {
        const int kvh = u & 3, nb = (u >> 2) & 63, b = u >> 8;
        const long t0 = (long)b * SEQ + (long)nb * 128;
        __syncthreads();
#pragma unroll
        for (int it = 0; it < 4; ++it) { const int idx = tid + 512 * it, row = idx >> 3, c = idx & 7; *(LAS v4u*)(Ks + row * 144 + c * 16) = kreg[it]; }
#pragma unroll
        for (int it = 0; it < 2; ++it) {
            const int p = tid & 127, c = (tid >> 7) + 4 * it; const v4u va = vreg[it][0], vbv = vreg[it][1];
            LAS unsigned* dst = Vt32 + (c * 8) * 130 + p;
            dst[0 * 130] = (va.x & 0xffffu) | (vbv.x << 16); dst[1 * 130] = (va.x >> 16) | (vbv.x & 0xffff0000u);
            dst[2 * 130] = (va.y & 0xffffu) | (vbv.y << 16); dst[3 * 130] = (va.y >> 16) | (vbv.y & 0xffff0000u);
            dst[4 * 130] = (va.z & 0xffffu) | (vbv.z << 16); dst[5 * 130] = (va.z >> 16) | (vbv.z & 0xffff0000u);
            dst[6 * 130] = (va.w & 0xffffu) | (vbv.w << 16); dst[7 * 130] = (va.w >> 16) | (vbv.w & 0xffff0000u);
        }
        __syncthreads();
        bf16x8 qc[2][4];
#pragma unroll
        for (int i = 0; i < 2; ++i)
#pragma unroll
            for (int ks = 0; ks < 4; ++ks) qc[i][ks] = qn[i][ks];
        if (u + (int)gridDim.x < 2048) ATTN_FETCH(u + (int)gridDim.x);
#pragma unroll
        for (int i = 0; i < 2; ++i) {
            const int wu = wave + 8 * i, g = wu & 3, qt = wu >> 2, head = kvh * 4 + g, i0 = 32 * qt;
            bf16x8 qf[4];
#pragma unroll
            for (int ks = 0; ks < 4; ++ks) qf[ks] = qc[i][ks];
            const float slope = exp2f(-0.5f * (float)(head + 1)), sink = sinks[head];
            const int kk_lo = (nb > 0) ? 0 : ((qt < 4) ? 4 - qt : 0);
            float mx = sink;
#pragma unroll 1
            for (int kk = kk_lo; kk < 5; ++kk) {
                f32x16 sc;
#pragma unroll
                for (int e = 0; e < 16; ++e) sc[e] = 0.f;
                const LAS unsigned char* kp = Ks + (32 * (qt + kk) + r) * 144 + 16 * hh;
#pragma unroll
                for (int ks = 0; ks < 4; ++ks) { const bf16x8 kf = *(const LAS bf16x8*)(kp + 32 * ks); sc = __builtin_amdgcn_mfma_f32_32x32x16_bf16(kf, qf[ks], sc, 0, 0, 0); }
                const int rdk = r + 128 - 32 * kk - 4 * hh;
#pragma unroll
                for (int e = 0; e < 16; ++e) {
                    const int dist = rdk - ((e & 3) + 8 * (e >> 2));
                    const float sv = fmaf(-slope, (float)dist, sc[e] * 0.125f);
                    mx = ((unsigned)dist < 128u) ? fmaxf(mx, sv) : mx;
                }
            }
            mx = fmaxf(mx, __shfl_xor(mx, 32));
            float sum = 0.f;
            f32x16 o0, o1;
#pragma unroll
            for (int e = 0; e < 16; ++e) { o0[e] = 0.f; o1[e] = 0.f; }
#pragma unroll 1
            for (int kk = kk_lo; kk < 5; ++kk) {
                f32x16 sc;
#pragma unroll
                for (int e = 0; e < 16; ++e) sc[e] = 0.f;
                const LAS unsigned char* kp = Ks + (32 * (qt + kk) + r) * 144 + 16 * hh;
#pragma unroll
                for (int ks = 0; ks < 4; ++ks) { const bf16x8 kf = *(const LAS bf16x8*)(kp + 32 * ks); sc = __builtin_amdgcn_mfma_f32_32x32x16_bf16(kf, qf[ks], sc, 0, 0, 0); }
                const int rdk = r + 128 - 32 * kk - 4 * hh;
#pragma unroll
                for (int e = 0; e < 16; ++e) {
                    const int dist = rdk - ((e & 3) + 8 * (e >> 2));
                    const float sv = fmaf(-slope, (float)dist, sc[e] * 0.125f);
                    const float ev = ((unsigned)dist < 128u) ? __expf(sv - mx) : 0.f;
                    sc[e] = ev; sum += ev;
                }
#pragma unroll
                for (int s2 = 0; s2 < 2; ++s2) {
                    v4u pw;
                    pw.x = pk2(sc[8 * s2 + 0], sc[8 * s2 + 1]); pw.y = pk2(sc[8 * s2 + 2], sc[8 * s2 + 3]);
                    pw.z = pk2(sc[8 * s2 + 4], sc[8 * s2 + 5]); pw.w = pk2(sc[8 * s2 + 6], sc[8 * s2 + 7]);
                    const bf16x8 pa = __builtin_bit_cast(bf16x8, pw);
                    const int key0 = 32 * (qt + kk) + 16 * s2 + 4 * hh;
                    const LAS unsigned char* v0p = Vtb + r * 520 + key0 * 2, * v1p = v0p + 32 * 520;
                    const v2u x0 = *(const LAS v2u*)(v0p), x1 = *(const LAS v2u*)(v0p + 16), y0 = *(const LAS v2u*)(v1p), y1 = *(const LAS v2u*)(v1p + 16);
                    v4u vw0, vw1; vw0.x = x0.x; vw0.y = x0.y; vw0.z = x1.x; vw0.w = x1.y; vw1.x = y0.x; vw1.y = y0.y; vw1.z = y1.x; vw1.w = y1.y;
                    o0 = __builtin_amdgcn_mfma_f32_32x32x16_bf16(pa, __builtin_bit_cast(bf16x8, vw0), o0, 0, 0, 0);
                    o1 = __builtin_amdgcn_mfma_f32_32x32x16_bf16(pa, __builtin_bit_cast(bf16x8, vw1), o1, 0, 0, 0);
                }
            }
            sum += __shfl_xor(sum, 32);
            const float inv = 1.0f / (sum + __expf(sink - mx));
#pragma unroll
            for (int e = 0; e < 16; ++e) {
                const int qr = (e & 3) + 8 * (e >> 2) + 4 * hh;
                const float ie = __shfl(inv, qr);
                GAS bf16* orow = ao + (size_t)(t0 + i0 + qr) * 1024 + head * 64 + r;
                orow[0] = (bf16)f2bf(o0[e] * ie); orow[32] = (bf16)f2bf(o1[e] * ie);
            }
        }
    }
#undef ATTN_FETCH
}

__device__ __forceinline__ void final_phase(PTT PT) {
    const int tid = opaque_tid(), lane = tid & 63, wave = tid >> 6;
    const int gw = opaque_bid() * 8 + wave, NGW = gridDim.x * 8;
    const GAS bf16* h = (const GAS bf16*)(WSP + WS_HA); const GAS float* ssq = (const GAS float*)(WSP + WS_SSQ + 7 * 4 * MiB); const GAS float* gf = INP(6);
    f32x4 g[4];
#pragma unroll
    for (int j = 0; j < 2; ++j) { g[2 * j] = *(const GAS f32x4*)(gf + 512 * j + lane * 8); g[2 * j + 1] = *(const GAS f32x4*)(gf + 512 * j + lane * 8 + 4); }
#if MK_DIAG
    float dA = 0.f; unsigned dM = 0;
    {
        const GAS unsigned long long* st = (const GAS unsigned long long*)(WSP + 4096);
        const float cyc = (float)st[2 * MK_DIAG_OP], us = (float)st[2 * MK_DIAG_OP + 1] * 0.01f, us2 = (float)st[2 * MK_DIAG_OP2 + 1] * 0.01f;
        if (MK_DIAG_MODE == 0) { dA = cyc / us * (1.0f / 100.0f); dM = (unsigned)(us * 1000.0f); }
        else { dA = us2 * (1.0f / 10.0f); dM = (unsigned)(us * 1000.0f); }
    }
#endif
#pragma unroll 8
    for (int r = gw; r < T; r += NGW) {
        const float rs = row_rstd(ssq, (size_t)r);
#pragma unroll
        for (int j = 0; j < 2; ++j) {
            const v4u w = *(const GAS v4u*)(h + (size_t)r * D + 512 * j + lane * 8);
            f32x4 o0, o1;
            o0[0] = bflo(w.x) * rs * g[2 * j][0]; o0[1] = bfhi(w.x) * rs * g[2 * j][1]; o0[2] = bflo(w.y) * rs * g[2 * j][2]; o0[3] = bfhi(w.y) * rs * g[2 * j][3];
            o1[0] = bflo(w.z) * rs * g[2 * j + 1][0]; o1[1] = bfhi(w.z) * rs * g[2 * j + 1][1]; o1[2] = bflo(w.w) * rs * g[2 * j + 1][2]; o1[3] = bfhi(w.w) * rs * g[2 * j + 1][3];
#if MK_DIAG
            { const unsigned e0 = (unsigned)r * 1024u + 512u * j + lane * 8u;
#pragma unroll
              for (int k = 0; k < 4; ++k) { if (e0 + k < dM) o0[k] += 1.0f; if (e0 + 4 + k < dM) o1[k] += 1.0f; }
              if (e0 == 0) o0[0] += dA; }
#endif
            GAS float* op = OUTP + (size_t)r * D + 512 * j + lane * 8;
            *(GAS f32x4*)op = o0; *(GAS f32x4*)(op + 4) = o1;
        }
    }
}

#define XB_TMO      128
#define XB_XCNT(j)  (256  + 64 * (j))
#define XB_XSUB(j)  (1280 + 64 * (j))
#define XB_XGEN(j)  (2304 + 64 * (j))
#define XB_TOP      3328
#define XB_TOPGEN   3392
#define XCD_BAR_WORDS 3456
#define XB_SPIN_CAP (1u << 18)

__device__ __forceinline__ unsigned xb_ld(unsigned* p)              { return __hip_atomic_load(p, __ATOMIC_RELAXED, __HIP_MEMORY_SCOPE_AGENT); }
__device__ __forceinline__ unsigned xb_add(unsigned* p, unsigned v) { return __hip_atomic_fetch_add(p, v, __ATOMIC_RELAXED, __HIP_MEMORY_SCOPE_AGENT); }
__device__ __forceinline__ unsigned xb_xcc_id() { return (unsigned)__builtin_amdgcn_s_getreg((3 << 11) | 20) & 0xFu; }
#define XB_SPIN(cond, bar) do { unsigned _sp = 0; while (cond) { __builtin_amdgcn_s_sleep(1); \
    if ((++_sp & 255u) == 0u) { if (xb_ld(&(bar)[XB_TMO])) break; if (_sp > XB_SPIN_CAP) { atomicAdd(&(bar)[XB_TMO], 1u); break; } } } } while (0)

struct XcdBarrier {
    unsigned* bar; unsigned x;
    volatile LAS unsigned* st;
};

__device__ __forceinline__ XcdBarrier xcd_barrier_post(unsigned* bar, volatile LAS unsigned* st) {
    XcdBarrier b; b.bar = bar; b.x = xb_xcc_id(); b.st = st;
    if (threadIdx.x == 0) (void)xb_add(&bar[XB_XCNT(b.x)], 1u);
    return b;
}
__device__ __forceinline__ void xcd_barrier_complete(unsigned* bar, unsigned x, unsigned& nloc, unsigned& nx) {
    const unsigned G = gridDim.x * gridDim.y * gridDim.z;
    unsigned sum, cnt, mine, sp = 0u;
    for (;;) {
        sum = 0u; cnt = 0u; mine = 0u;
#pragma unroll
        for (unsigned j = 0; j < 16; ++j) { const unsigned c = xb_ld(&bar[XB_XCNT(j)]); sum += c; cnt += (c > 0u) ? 1u : 0u; mine = (j == x) ? c : mine; }
        if (sum == G) break;
        __builtin_amdgcn_s_sleep(1);
        if ((++sp & 255u) == 0u) { if (xb_ld(&bar[XB_TMO])) break; if (sp > XB_SPIN_CAP) { atomicAdd(&bar[XB_TMO], 1u); break; } }
    }
    nloc = mine > 0u ? mine : 1u; nx = cnt > 0u ? cnt : 1u;
}

__device__ __forceinline__ void xcd_barrier(const XcdBarrier& b) {
    asm volatile("s_waitcnt vmcnt(0)" ::: "memory");
    __syncthreads();
    if (threadIdx.x == 0) {
        unsigned* bar = b.bar;
        __builtin_amdgcn_s_waitcnt(0);
        unsigned nloc = b.st[0], nx = b.st[1];
        if (nloc == 0u) { xcd_barrier_complete(bar, b.x, nloc, nx); b.st[0] = nloc; b.st[1] = nx; }
        const unsigned old = xb_add(&bar[XB_XSUB(b.x)], 1u);
        const unsigned gen = old / nloc;
        if (old + 1u == (gen + 1u) * nloc) {
            __builtin_amdgcn_fence(__ATOMIC_RELEASE, "agent");
            asm volatile("s_waitcnt vmcnt(0)" ::: "memory");
            const unsigned og = xb_add(&bar[XB_TOP], 1u);
            const unsigned tg = og / nx;
            if (og + 1u == (tg + 1u) * nx) xb_add(&bar[XB_TOPGEN], 1u);
            else XB_SPIN(xb_ld(&bar[XB_TOPGEN]) == tg, bar);
            __builtin_amdgcn_fence(__ATOMIC_ACQUIRE, "agent");
            xb_add(&bar[XB_XGEN(b.x)], 1u);
            asm volatile("s_waitcnt vmcnt(0)" ::: "memory");
        } else {
            XB_SPIN(xb_ld(&bar[XB_XGEN(b.x)]) == gen, bar);
            __builtin_amdgcn_fence(__ATOMIC_ACQUIRE, "agent");
            asm volatile("s_waitcnt vmcnt(0)" ::: "memory");
        }
    }
    __syncthreads();
}

enum { OP_PRO = 0, OP_GEMM = 1, OP_SPATIAL = 2, OP_FIX = 3, OP_ATTN = 4, OP_FINAL = 5 };
constexpr int N_OPS = 18;
__host__ __device__ inline int op_kind(int op) {
    switch (op) { case 0: return OP_PRO; case 2: return OP_SPATIAL; case 5: case 13: return OP_FIX; case 10: return OP_ATTN; case 17: return OP_FINAL; default: return OP_GEMM; }
}
__host__ __device__ inline bool op_sync_after(int op) { return !(op == 6 || op == 14 || op == 17); }

__device__ __forceinline__ void make_gemm(int op, PTT PT, pg8::Gemm& g, Epi& E) {
    GAS unsigned char* ws = WSP;
    GAS bf16* HA = (GAS bf16*)(ws + WS_HA); GAS bf16* HB = (GAS bf16*)(ws + WS_HB); GAS bf16* PE = (GAS bf16*)(ws + WS_PE); GAS bf16* BIG = (GAS bf16*)(ws + WS_BIG);
    GAS float* SSQ = (GAS float*)(ws + WS_SSQ); const size_t SS = (size_t)T * 16;
    GAS bf16* ACT = (GAS bf16*)(ws + WS_ACT);
    E.mode = EM_PLAIN; E.out = nullptr; E.ldo = 1024; E.res = nullptr; E.pe = nullptr; E.ssq_in = nullptr; E.ssq_out = nullptr; E.bias = nullptr; E.out_k = nullptr; E.out_v = nullptr; E.cw = nullptr; E.skip = 0; E.par = nullptr;
    g.A = (const pg8::bf16_t*)(nullptr); g.Bt = (const pg8::bf16_t*)(nullptr); g.M = T; g.N = 1024; g.K = 1024; g.aperm = 0;
    const int layer = (op >= 12) ? 1 : 0;
    switch (op) {
        case 1:  g.A = (const pg8::bf16_t*)(HA); g.Bt = (const pg8::bf16_t*)((const GAS bf16*)(ws + WS_WIN)); g.N = 2048; E.mode = EM_GELU; E.out = BIG; E.ldo = 2048; E.ssq_in = SSQ; E.ssq_out = SSQ + SS; break;
        case 3:  g.A = (const pg8::bf16_t*)(BIG + (size_t)T * 2048); g.Bt = (const pg8::bf16_t*)((const GAS bf16*)(ws + WS_WOUT)); E.mode = EM_RES; E.out = HB; E.res = HA; E.ssq_out = SSQ + 2 * SS; break;
        case 4: case 12:
            g.A = (const pg8::bf16_t*)(layer ? HA : HB); g.Bt = (const pg8::bf16_t*)((const GAS bf16*)(ws + WS_WUP) + (size_t)layer * NUP * 1024); g.N = NUP; g.aperm = 1;
            E.mode = EM_UPCONV; E.out = ACT; E.ldo = DFF; E.ssq_in = SSQ + (layer ? 5 : 2) * SS; E.ssq_out = (GAS float*)(ws + WS_RAW);
            E.cw = INP(17) + (size_t)layer * 3 * NUP; E.bias = INP(18) + (size_t)layer * NUP; E.out_k = (GAS bf16*)(ws + 512 * 1024); break;
        case 6: case 14:
            g.A = (const pg8::bf16_t*)(ACT); g.Bt = (const pg8::bf16_t*)((const GAS bf16*)(ws + WS_WDN) + (size_t)layer * 1024 * DFF); g.K = DFF;
            E.mode = EM_RES; E.out = layer ? HB : HA; E.res = layer ? HA : HB; E.ssq_out = SSQ + (layer ? 6 : 3) * SS; break;
        case 7: case 15:
            g.A = (const pg8::bf16_t*)((const GAS bf16*)(ws + WS_PB) + (size_t)layer * T * 256); g.Bt = (const pg8::bf16_t*)((const GAS bf16*)(ws + WS_WPE) + (size_t)layer * 1024 * 256); g.K = 256; E.mode = EM_PLAIN; E.out = PE; break;
        case 8: case 16: {
            const GAS bf16* hin = layer ? HB : HA; GAS bf16* hout = layer ? HA : HB;
            g.A = (const pg8::bf16_t*)(hin); g.Bt = (const pg8::bf16_t*)((const GAS bf16*)(ws + WS_WG) + (size_t)layer * 1024 * 1024); E.mode = EM_GATE; E.out = hout; E.res = hin; E.pe = PE;
            E.ssq_in = SSQ + (layer ? 6 : 3) * SS; E.ssq_out = SSQ + (layer ? 7 : 4) * SS; E.bias = INP(22) + layer * 1024; break; }
        case 9:  g.A = (const pg8::bf16_t*)(HB); g.Bt = (const pg8::bf16_t*)((const GAS bf16*)(ws + WS_WQKV)); g.N = 1536; E.mode = EM_QKV; E.out = BIG; E.out_k = BIG + (size_t)T * 1024; E.out_v = BIG + (size_t)T * 1280; E.ssq_in = SSQ + 4 * SS; break;
        case 11: g.A = (const pg8::bf16_t*)(BIG + (size_t)T * 1536); g.Bt = (const pg8::bf16_t*)((const GAS bf16*)(ws + WS_WO)); E.mode = EM_RES; E.out = HA; E.res = HB; E.ssq_out = SSQ + 5 * SS; break;
        default: break;
    }
}

__global__ void __launch_bounds__(512, 2) fwd_kernel(Args args) {
    extern __shared__ __attribute__((aligned(16))) unsigned char lds_raw[];
    LAS unsigned char* lds = (LAS unsigned char*)lds_raw;
    cg::grid_group grid = cg::this_grid();
    {
        LAS unsigned long long* PW = (LAS unsigned long long*)(lds + 131072);
        if (threadIdx.x == 0) {
#pragma unroll
            for (int i = 0; i < 23; ++i) PW[i] = (unsigned long long)args.in[i];
            PW[23] = (unsigned long long)args.out; PW[24] = (unsigned long long)args.ws;
            ((LAS unsigned*)(lds + 131072 + 512))[0] = 0u; ((LAS unsigned*)(lds + 131072 + 512))[1] = 0u;
        }
        __syncthreads();
    }
    PTT PT = (PTT)(lds + 131072);
    if (threadIdx.x == 0) {
        unsigned* bar0 = (unsigned*)(args.ws + WS_BAR); const unsigned x0 = xb_xcc_id();
        const unsigned rank0 = xb_add(&bar0[XB_XCNT(x0)], 1u);
        ((LAS unsigned*)(lds + 131072 + 512))[2] = x0; ((LAS unsigned*)(lds + 131072 + 512))[3] = rank0;
    }
    __syncthreads();
    for (int op = args.op_lo; op < args.op_hi; ++op) {
        const int kind = op_kind(op);
#if MK_DIAG
        if (blockIdx.x == 0 && threadIdx.x == 0) { GAS unsigned long long* st = (GAS unsigned long long*)(WSP + 4096); st[64 + 2 * op] = (unsigned long long)clock64(); st[65 + 2 * op] = (unsigned long long)wall_clock64(); }
#endif
        for (int rep = 0; rep < ((MK_REP_MASK >> op) & 1u ? 2 : 1); ++rep) {
        if (rep) __syncthreads();
        if (kind == OP_GEMM) {
            pg8::Gemm g; Epi E; make_gemm(op, PT, g, E); E.skip = (rep > 0 && MK_REP_NOEPI) ? 1 : 0; E.par = (LAS float*)(lds + 131072 + 1024);
            pg8::StaticOrder S; S.init(g.M, g.N, (int)gridDim.x, (int)blockIdx.x);
            pg8::gemm_phase<Epi, pg8::StaticOrder, false>(lds, g, S, E, nullptr);
        } else if (kind == OP_PRO) {
            prologue(PT, lds);
        } else if (kind == OP_SPATIAL) {
            spatial_phase(PT, lds);
        } else if (kind == OP_FIX) {
            const int layer = (op >= 12) ? 1 : 0;
            fix_phase((const GAS float*)(WSP + WS_RAW), (GAS bf16*)(WSP + WS_ACT), INP(17) + (size_t)layer * 3 * NUP, INP(18) + (size_t)layer * NUP);
        } else if (kind == OP_ATTN) {
            attn_phase(PT, lds);
        } else {
            final_phase(PT);
        }
        }
#if MK_DIAG
        if (blockIdx.x == 0 && threadIdx.x == 0) { GAS unsigned long long* st = (GAS unsigned long long*)(WSP + 4096); st[2 * op] = (unsigned long long)clock64() - st[64 + 2 * op]; st[1 + 2 * op] = (unsigned long long)wall_clock64() - st[65 + 2 * op]; }
#endif
        if (op_sync_after(op) && op + 1 < args.op_hi) { if (args.op_lo < 0) grid.sync();   XcdBarrier xbar; xbar.bar = (unsigned*)(WSP + WS_BAR); xbar.st = (volatile LAS unsigned*)(lds + 131072 + 512); xbar.x = (unsigned)__builtin_amdgcn_readfirstlane((int)xbar.st[2]); xcd_barrier(xbar); }
        else __syncthreads();
    }
}
}

#ifndef MK_SINGLE
#define MK_SINGLE 1
#endif
#ifndef MK_MAXOP
#define MK_MAXOP N_OPS
#endif
extern "C" void kernel_launch(void* const* d_in, const int* in_sizes, int n_in, void* d_out, int out_size, void* d_ws, size_t ws_size, hipStream_t stream) {
    using namespace mk;
    static int grid = 0;
    if (grid == 0) {
        if (n_in != 23 || ws_size < WS_END) { fprintf(stderr, "kernel_launch: unexpected n_in %d / ws_size %zu\n", n_in, ws_size); grid = -1; return; }
        int dev = 0, cus = 0, per_cu = 0;
        hipGetDevice(&dev); hipDeviceGetAttribute(&cus, hipDeviceAttributeMultiprocessorCount, dev);
        if (hipFuncSetAttribute((const void*)fwd_kernel, hipFuncAttributeMaxDynamicSharedMemorySize, LDS_BYTES) != hipSuccess) { fprintf(stderr, "kernel_launch: hipFuncSetAttribute failed\n"); grid = -1; return; }
        hipOccupancyMaxActiveBlocksPerMultiprocessor(&per_cu, (const void*)fwd_kernel, 512, LDS_BYTES);
        if (per_cu < 1) { fprintf(stderr, "kernel_launch: occupancy query says %d blocks per CU\n", per_cu); per_cu = 1; }
        (void)hipGetLastError();
        grid = cus;
    }
    if (grid < 0) return;
    Args a{};
    for (int i = 0; i < 23; ++i) a.in[i] = (const float*)d_in[i];
    a.out = (float*)d_out; a.ws = (unsigned char*)d_ws;
#if MK_SINGLE
    if (hipMemsetAsync((char*)d_ws + WS_BAR, 0, WS_BAR_BYTES, stream) != hipSuccess) { fprintf(stderr, "kernel_launch: hipMemsetAsync failed\n"); return; }
    a.op_lo = 0; a.op_hi = MK_MAXOP;
    void* kargs[] = {&a};
    hipError_t e = hipLaunchCooperativeKernel((const void*)fwd_kernel, dim3(grid), dim3(512), kargs, LDS_BYTES, stream);
    if (e != hipSuccess) fprintf(stderr, "cooperative launch failed: %s (grid %d)\n", hipGetErrorString(e), grid);
#else
    int lo = 0;
    for (int op = 0; op < MK_MAXOP; ++op) {
        if (op_sync_after(op) || op == MK_MAXOP - 1) {
            a.op_lo = lo; a.op_hi = op + 1; lo = op + 1;
            hipLaunchKernelGGL(fwd_kernel, dim3(grid), dim3(512), LDS_BYTES, stream, a);
        }
    }
#endif
}
```
